# Optimizing an MI355X kernel written in HIP

```python
import math
import jax, jax.numpy as jnp
from jax import lax
import numpy as np

D_MODEL = 1024
BATCH = 16
SEQ = 2048
DEPTH = 1

HEAD_DIM = 64
ATTN_SCALE = HEAD_DIM ** -0.5
NSA_HEADS = 8
NSA_KV = 2
NSA_REP = NSA_HEADS // NSA_KV
NSA_WIDTH = NSA_HEADS * HEAD_DIM
CMP_LEN = 32
CMP_STRIDE = 16
CMP_HIDDEN = 256
SEL_LEN = 64
SEL_TOPN = 8
NSA_WINDOW = 512
SWA_HEADS = 8
SWA_KV = 2
SWA_REP = SWA_HEADS // SWA_KV
SWA_WIDTH = SWA_HEADS * HEAD_DIM
SWA_WINDOW = 128
Q_BLOCK = 128
D_FF = 2816
FFN_RES = 0.5
RMS_EPS = 1e-6
NEG_INF = -1e30
SEL_BONUS = 1e4
IN_SIZES = (NSA_WIDTH, 2 * NSA_KV * HEAD_DIM, 2 * NSA_KV * HEAD_DIM, 2 * NSA_KV * HEAD_DIM,
            3 * NSA_HEADS, SWA_WIDTH, 2 * SWA_KV * HEAD_DIM, 2 * D_MODEL)
IN_WIDTH = NSA_WIDTH + 6 * NSA_KV * HEAD_DIM + 3 * NSA_HEADS + SWA_WIDTH + 2 * SWA_KV * HEAD_DIM + 2 * D_MODEL

kernel_name = "hybrid_nsa_swa_sink_macaron_adaln"


def alibi_slopes(n):
    return np.array([2.0 ** (-8.0 * (h + 1) / n) for h in range(n)], dtype=np.float32)


def rms_norm(x, g):
    xf = x.astype(jnp.float32)
    y = xf * lax.rsqrt(jnp.mean(xf * xf, axis=-1, keepdims=True) + RMS_EPS)
    return y.astype(x.dtype) * g


def modulate(h, g, shift, scale):
    return rms_norm(h, g) * (1.0 + scale[:, None, :]) + shift[:, None, :]


def swiglu(u, wg, wu, wd):
    return (jax.nn.silu(u @ wg) * (u @ wu)) @ wd


def split_cols(a, sizes):
    outs, off = [], 0
    for n in sizes:
        outs.append(a[..., off:off + n])
        off += n
    return outs


def split_kv(a, groups):
    B, S, _ = a.shape
    a = a.reshape(B, S, 2, groups, HEAD_DIM)
    return a[:, :, 0], a[:, :, 1]


def banded_attention(q, k, v, slopes, window, sinks=None):
    B, S, KH, R, dh = q.shape
    nb = S // Q_BLOCK
    pad = -(-window // Q_BLOCK) * Q_BLOCK
    span = pad + Q_BLOCK
    kp = jnp.pad(k, ((0, 0), (pad, 0), (0, 0), (0, 0)))
    vp = jnp.pad(v, ((0, 0), (pad, 0), (0, 0), (0, 0)))
    qb = jnp.moveaxis(q.reshape(B, nb, Q_BLOCK, KH, R, dh), 1, 0)
    sl = jnp.asarray(slopes)[:, :, None, None]

    def one(args):
        b, qblk = args
        start = b * Q_BLOCK
        kblk = lax.dynamic_slice_in_dim(kp, start, span, axis=1)
        vblk = lax.dynamic_slice_in_dim(vp, start, span, axis=1)
        q_pos = start + jnp.arange(Q_BLOCK)
        k_pos = start - pad + jnp.arange(span)
        dist = q_pos[:, None] - k_pos[None, :]
        valid = (dist >= 0) & (dist < window) & (k_pos[None, :] >= 0)
        s = jnp.einsum('bqkrd,bskd->bkrqs', qblk, kblk).astype(jnp.float32) * ATTN_SCALE
        s = s - sl * dist.astype(jnp.float32)
        s = jnp.where(valid, s, NEG_INF)
        if sinks is not None:
            sink = jnp.broadcast_to(sinks.astype(jnp.float32)[None, :, :, None, None], (B, KH, R, Q_BLOCK, 1))
            p = jax.nn.softmax(jnp.concatenate([s, sink], axis=-1), axis=-1)[..., :-1]
        else:
            p = jax.nn.softmax(s, axis=-1)
        return jnp.einsum('bkrqs,bskd->bqkrd', p.astype(v.dtype), vblk)

    o = lax.map(one, (jnp.arange(nb), qb))
    return jnp.moveaxis(o, 0, 1).reshape(B, S, KH, R, dh)


def nsa_compress(kraw, pos, w1, w2):
    S = kraw.shape[1]
    nc = (S - CMP_LEN) // CMP_STRIDE + 1
    idx = np.arange(nc)[:, None] * CMP_STRIDE + np.arange(CMP_LEN)[None, :]
    blocks = kraw[:, idx] + pos[None, None, :, None, :]
    h = jax.nn.gelu(jnp.einsum('bnlgd,ldh->bngh', blocks, w1))
    return jnp.einsum('bngh,hd->bngd', h, w2)


def selected_attention(q, k, v, idx, slopes):
    B, S, G, R, dh = q.shape
    n = idx.shape[-1]
    nqb = S // SEL_LEN
    qb = jnp.moveaxis(q.reshape(B, nqb, SEL_LEN, G, R, dh), 1, 0)
    ib = jnp.moveaxis(idx.reshape(B, nqb, SEL_LEN, G, n), 1, 0)
    bi = jnp.arange(B)[:, None, None, None]
    gi = jnp.arange(G)[None, None, :, None]
    offs = jnp.arange(SEL_LEN)
    sl = jnp.asarray(slopes)[None, None, :, :, None]

    def one(args):
        b, qblk, iblk = args
        t = b * SEL_LEN + jnp.arange(SEL_LEN)
        tok = (iblk[..., None] * SEL_LEN + offs).reshape(B, SEL_LEN, G, n * SEL_LEN)
        ks = k[bi, tok, gi]
        vs = v[bi, tok, gi]
        dist = (t[None, :, None, None] - tok)[:, :, :, None, :]
        s = jnp.einsum('bqgrd,bqgsd->bqgrs', qblk, ks).astype(jnp.float32) * ATTN_SCALE
        s = s - sl * dist.astype(jnp.float32)
        s = jnp.where(dist >= 0, s, NEG_INF)
        p = jax.nn.softmax(s, axis=-1)
        return jnp.einsum('bqgrs,bqgsd->bqgrd', p.astype(v.dtype), vs)

    o = lax.map(one, (jnp.arange(nqb), qb, ib))
    return jnp.moveaxis(o, 0, 1).reshape(B, S, G, R, dh)


def nsa_attention(q, kv_c, kv_s, kv_w, gates, pos_k, w1_k, w2_k, pos_v, w1_v, w2_v):
    B, S = q.shape[0], q.shape[1]
    q = q.reshape(B, S, NSA_KV, NSA_REP, HEAD_DIM)
    slopes = alibi_slopes(NSA_HEADS).reshape(NSA_KV, NSA_REP)
    kc_raw, vc_raw = split_kv(kv_c, NSA_KV)
    k_s, v_s = split_kv(kv_s, NSA_KV)
    k_w, v_w = split_kv(kv_w, NSA_KV)
    kc = nsa_compress(kc_raw, pos_k, w1_k, w2_k)
    vc = nsa_compress(vc_raw, pos_v, w1_v, w2_v)
    nc = kc.shape[1]
    t = np.arange(S)
    cmp_start = np.arange(nc) * CMP_STRIDE
    dist_c = t[:, None] - (cmp_start + CMP_LEN - 1)[None, :]
    pen_c = (slopes[:, :, None, None] * dist_c[None, None]).astype(np.float32)
    s = jnp.einsum('bsgrd,bngd->bgrsn', q, kc).astype(jnp.float32) * ATTN_SCALE - pen_c
    p_cmp = jax.nn.softmax(jnp.where(dist_c >= 0, s, NEG_INF), axis=-1)
    p_cmp = jnp.where((t >= CMP_LEN - 1)[:, None], p_cmp, 0.0)
    o_cmp = jnp.einsum('bgrsn,bngd->bsgrd', p_cmp.astype(vc.dtype), vc)
    nsel = S // SEL_LEN
    n_top = min(SEL_TOPN, nsel)
    sel_start = np.arange(nsel) * SEL_LEN
    overlap = ((cmp_start[:, None] < sel_start[None, :] + SEL_LEN)
               & (cmp_start[:, None] + CMP_LEN > sel_start[None, :])).astype(np.float32)
    imp = jnp.einsum('bgrsn,nj->bsgj', p_cmp, overlap)
    cur = t // SEL_LEN
    jj = np.arange(nsel)
    valid_sel = (sel_start[None, :] <= t[:, None])[:, None, :]
    forced = ((jj[None, :] == 0) | (jj[None, :] == cur[:, None]) | (jj[None, :] == cur[:, None] - 1))[:, None, :]
    score = jnp.where(forced, SEL_BONUS, jnp.where(valid_sel, imp, -1.0))
    _, idx = lax.top_k(score, n_top)
    o_slc = selected_attention(q, k_s, v_s, idx, slopes)
    o_win = banded_attention(q, k_w, v_w, slopes, NSA_WINDOW)
    g = jax.nn.sigmoid(gates.reshape(B, S, NSA_KV, NSA_REP, 3))
    o = g[..., 0:1] * o_cmp + g[..., 1:2] * o_slc + g[..., 2:3] * o_win
    return o.reshape(B, S, NSA_WIDTH)


def swa_sink_attention(q, kv, sinks):
    B, S = q.shape[0], q.shape[1]
    q = q.reshape(B, S, SWA_KV, SWA_REP, HEAD_DIM)
    k, v = split_kv(kv, SWA_KV)
    slopes = alibi_slopes(SWA_HEADS).reshape(SWA_KV, SWA_REP)
    o = banded_attention(q, k, v, slopes, SWA_WINDOW, sinks=sinks)
    return o.reshape(B, S, SWA_WIDTH)


def hybrid_mixer(u, w_in, cmp_pos_k, cmp_w1_k, cmp_w2_k, cmp_pos_v, cmp_w1_v, cmp_w2_v,
                 sinks, w_up_a, w_up_b, w_out):
    proj = u @ w_in
    q_n, kv_c, kv_s, kv_w, g_n, q_s, kv_b, g_m = split_cols(proj, IN_SIZES)
    y_a = nsa_attention(q_n, kv_c, kv_s, kv_w, g_n, cmp_pos_k, cmp_w1_k, cmp_w2_k,
                        cmp_pos_v, cmp_w1_v, cmp_w2_v)
    y_b = swa_sink_attention(q_s, kv_b, sinks)
    gate_a, gate_b = g_m[..., :D_MODEL], g_m[..., D_MODEL:]
    merged = jax.nn.sigmoid(gate_a) * (y_a @ w_up_a) + jax.nn.sigmoid(gate_b) * (y_b @ w_up_b)
    return merged @ w_out


def setup_inputs(seed: int = 0) -> dict:
    key = jax.random.key(seed)
    ks = jax.random.split(key, 25)
    L, D = DEPTH, D_MODEL

    def nrm(k, shape, scale):
        return jax.random.normal(k, shape, jnp.float32) * scale

    return {
        "x": nrm(ks[0], (BATCH, SEQ, D), 1.0),
        "c": nrm(ks[1], (BATCH, D), 1.0),
        "w_ada": nrm(ks[2], (L, D, 9 * D), D ** -0.5),
        "b_ada": nrm(ks[3], (L, 9 * D), 0.01),
        "g_ffn1": 1.0 + nrm(ks[4], (L, D), 0.02),
        "w1_gate": nrm(ks[5], (L, D, D_FF), D ** -0.5),
        "w1_up": nrm(ks[6], (L, D, D_FF), D ** -0.5),
        "w1_down": nrm(ks[7], (L, D_FF, D), D_FF ** -0.5),
        "g_mix": 1.0 + nrm(ks[8], (L, D), 0.02),
        "w_in": nrm(ks[9], (L, D, IN_WIDTH), D ** -0.5),
        "cmp_pos_k": nrm(ks[10], (L, CMP_LEN, HEAD_DIM), 0.1),
        "cmp_w1_k": nrm(ks[11], (L, CMP_LEN, HEAD_DIM, CMP_HIDDEN), (CMP_LEN * HEAD_DIM) ** -0.5),
        "cmp_w2_k": nrm(ks[12], (L, CMP_HIDDEN, HEAD_DIM), CMP_HIDDEN ** -0.5),
        "cmp_pos_v": nrm(ks[13], (L, CMP_LEN, HEAD_DIM), 0.1),
        "cmp_w1_v": nrm(ks[14], (L, CMP_LEN, HEAD_DIM, CMP_HIDDEN), (CMP_LEN * HEAD_DIM) ** -0.5),
        "cmp_w2_v": nrm(ks[15], (L, CMP_HIDDEN, HEAD_DIM), CMP_HIDDEN ** -0.5),
        "sinks": nrm(ks[16], (L, SWA_KV, SWA_REP), 1.0),
        "w_up_a": nrm(ks[17], (L, NSA_WIDTH, D), NSA_WIDTH ** -0.5),
        "w_up_b": nrm(ks[18], (L, SWA_WIDTH, D), SWA_WIDTH ** -0.5),
        "w_out": nrm(ks[19], (L, D, D), D ** -0.5),
        "g_ffn2": 1.0 + nrm(ks[20], (L, D), 0.02),
        "w2_gate": nrm(ks[21], (L, D, D_FF), D ** -0.5),
        "w2_up": nrm(ks[22], (L, D, D_FF), D ** -0.5),
        "w2_down": nrm(ks[23], (L, D_FF, D), D_FF ** -0.5),
        "g_final": 1.0 + nrm(ks[24], (D,), 0.02),
    }


def reference(x, c, w_ada, b_ada, g_ffn1, w1_gate, w1_up, w1_down, g_mix, w_in,
              cmp_pos_k, cmp_w1_k, cmp_w2_k, cmp_pos_v, cmp_w1_v, cmp_w2_v, sinks,
              w_up_a, w_up_b, w_out, g_ffn2, w2_gate, w2_up, w2_down, g_final):
    h = x
    for l in range(DEPTH):
        mod = jax.nn.silu(c) @ w_ada[l] + b_ada[l]
        sh1, sc1, gt1, sh2, sc2, gt2, sh3, sc3, gt3 = jnp.split(mod, 9, axis=-1)
        u = modulate(h, g_ffn1[l], sh1, sc1)
        h = h + FFN_RES * gt1[:, None, :] * swiglu(u, w1_gate[l], w1_up[l], w1_down[l])
        u = modulate(h, g_mix[l], sh2, sc2)
        y = hybrid_mixer(u, w_in[l], cmp_pos_k[l], cmp_w1_k[l], cmp_w2_k[l], cmp_pos_v[l],
                         cmp_w1_v[l], cmp_w2_v[l], sinks[l], w_up_a[l], w_up_b[l], w_out[l])
        h = h + gt2[:, None, :] * y
        u = modulate(h, g_ffn2[l], sh3, sc3)
        h = h + FFN_RES * gt3[:, None, :] * swiglu(u, w2_gate[l], w2_up[l], w2_down[l])
    return rms_norm(h, g_final)
```

```cpp
#include <hip/hip_runtime.h>
#include <hip/hip_cooperative_groups.h>
#include <cstdio>
#include <cstdint>
namespace cg = cooperative_groups;

#ifndef NLAUNCH
#define NLAUNCH 1
#endif

#define DI __device__ __forceinline__
#define LAS __attribute__((address_space(3)))
typedef unsigned short bf16_t;
typedef short bf16x8 __attribute__((ext_vector_type(8)));
typedef short s16x4 __attribute__((ext_vector_type(4)));
typedef float f32x2 __attribute__((ext_vector_type(2)));
typedef float f32x4 __attribute__((ext_vector_type(4)));
typedef float f32x16 __attribute__((ext_vector_type(16)));
typedef unsigned u32x2 __attribute__((ext_vector_type(2)));
typedef unsigned u32x4 __attribute__((ext_vector_type(4)));
typedef __bf16 bf16v2 __attribute__((ext_vector_type(2)));

constexpr int NB = 16, SEQ = 2048, DM = 1024, MTOK = NB * SEQ, FF = 2816, LDP = 4352, INW = 4120, MODW = 9216;
constexpr float LOG2E = 1.4426950408889634f;
constexpr float C1 = 0.125f * LOG2E;

constexpr size_t SZ_WGU = (size_t)5632 * 1024 * 2, SZ_WD = (size_t)1024 * 2816 * 2;
constexpr size_t OFF_WGU1 = 0;
constexpr size_t OFF_WD1 = OFF_WGU1 + SZ_WGU;
constexpr size_t OFF_WGU2 = OFF_WD1 + SZ_WD;
constexpr size_t OFF_WD2 = OFF_WGU2 + SZ_WGU;
constexpr size_t OFF_WIN = OFF_WD2 + SZ_WD;
constexpr size_t OFF_WUPA = OFF_WIN + (size_t)LDP * 1024 * 2;
constexpr size_t OFF_WUPB = OFF_WUPA + (size_t)1024 * 512 * 2;
constexpr size_t OFF_WOUT = OFF_WUPB + (size_t)1024 * 512 * 2;
constexpr size_t OFF_W1T = OFF_WOUT + (size_t)1024 * 1024 * 2;
constexpr size_t OFF_MOD = OFF_W1T + (size_t)2 * 256 * 2048 * 2;
constexpr size_t OFF_CB = OFF_MOD + (size_t)NB * MODW * 4;
constexpr size_t OFF_U = OFF_CB + 4096;
constexpr size_t OFF_ACT = OFF_U + (size_t)MTOK * 1024 * 2;
constexpr size_t OFF_YA = OFF_ACT + (size_t)MTOK * LDP * 2;
constexpr size_t OFF_YB = OFF_YA + (size_t)MTOK * 512 * 2;
constexpr size_t OFF_KVC = OFF_YB + (size_t)MTOK * 512 * 2;
constexpr size_t SZ_KVC1 = (size_t)NB * 2 * SEQ * 64;
constexpr size_t OFF_HID = OFF_KVC + 2 * SZ_KVC1 * 2 + 8192;
constexpr size_t OFF_KC = OFF_HID + (size_t)2 * 4096 * 256 * 2;
constexpr size_t OFF_GT = OFF_KC + (size_t)2 * 4096 * 64 * 2;
constexpr size_t OFF_SHW2 = OFF_GT + (size_t)3 * NB * DM * 4;
constexpr size_t OFF_SHW3 = OFF_SHW2 + (size_t)NB * LDP * 4;
constexpr size_t OFF_PS = OFF_SHW3 + (size_t)NB * 5632 * 4;
constexpr size_t OFF_SH = OFF_PS + (size_t)MTOK * 16 * 4;
constexpr int NSHU = 17 + 22;
constexpr size_t OFF_BAR = OFF_SH + (size_t)NSHU * 256 * 1024 * 2;
constexpr size_t OFF_WUP = OFF_BAR + 16384;
constexpr size_t WS_END = OFF_WUP + (size_t)8 * 256 * 1024 * 2;

struct Params {
  const float* in[25];
  float* out;
  unsigned char* ws;
  int ph_lo, ph_hi;
};

DI unsigned pk2(float lo, float hi) { bf16v2 v = __builtin_convertvector((f32x2){lo, hi}, bf16v2); return __builtin_bit_cast(unsigned, v); }
DI float bf2f(unsigned short v) { return __uint_as_float((unsigned)v << 16); }
DI float bflo(unsigned v) { return __uint_as_float(v << 16); }
DI float bfhi(unsigned v) { return __uint_as_float(v & 0xffff0000u); }
DI float fexp2(float x) { return __builtin_amdgcn_exp2f(x); }
DI float frcp(float x) { return __builtin_amdgcn_rcpf(x); }
DI float sigm(float x) { return frcp(1.f + fexp2(-LOG2E * x)); }
DI float silu_(float x) { return x * sigm(x); }
DI float gelu_tanh(float x) { const float z = 0.7978845608f * (x + 0.044715f * x * x * x); return x * sigm(2.f * z); }
DI int otid() { int t = threadIdx.x; asm volatile("" : "+v"(t)); return t; }
DI float wave_sum(float v) {
#pragma unroll
  for (int o = 1; o < 64; o <<= 1) v += __shfl_xor(v, o);
  return v;
}

constexpr int HT_B = 128 * 64 * 2;
DI int lds_byte(int r, int c) { const int st = (r >> 4) * 2 + (c >> 5), rr = r & 15, cc = c & 31, ob = rr * 64 + cc * 2; return st * 1024 + (ob ^ (((ob >> 9) & 1) << 5)); }
DI void stage_rc(int b, int& R, int& C) { const int st = b / 1024, sb = b % 1024, swz = sb ^ (((sb >> 9) & 1) << 5); R = (st >> 1) * 16 + swz / 64; C = (st & 1) * 32 + (swz % 64) / 2; }
DI int perm32(int rho) { const int n = rho >> 4, i = rho & 15; return 8 * (i >> 2) + 4 * n + (i & 3); }

struct UnitD { const bf16_t* a; const bf16_t* b; int brow, bcol, aux; };
DI bool unit_of(int L, int nM, int nN, int& pm, int& pn) {
  const int nwg = nM * nN; if (L >= nwg) return false;
  int wgid = L; { const int q = nwg / 8, r = nwg % 8, xcd = wgid % 8, off = wgid / 8; wgid = (xcd < r ? xcd * (q + 1) : r * (q + 1) + (xcd - r) * q) + off; }
  const int nig = 8 * nN, gid = wgid / nig, fm = gid * 8, gsz = (nM - fm) < 8 ? (nM - fm) : 8;
  pm = fm + ((wgid % nig) % gsz); pn = (wgid % nig) / gsz; return true;
}
struct StdUnits { const bf16_t* A; int lda; const bf16_t* Bt; int ldb; int nM, nN;
  DI bool next(int i, UnitD& d) const { int pm, pn; if (!unit_of(i * (int)gridDim.x + (int)blockIdx.x, nM, nN, pm, pn)) return false;
    d.brow = pm * 256; d.bcol = pn * 256; d.aux = 0; d.a = A + (size_t)d.brow * lda; d.b = Bt + (size_t)d.bcol * ldb; return true; } };

#define EPI_ARGS const f32x4 (&acc)[2][2][4][2], int brow, int bcol, int aux, int wr, int wc, int fr, int fq
template <bool HALFK = false, class Units, class Epi>
DI void gemm_stream(const Units& S, const int lda, const int ldb, const int K, const Epi& epi, LAS unsigned char* lds) {
  const int tid = threadIdx.x, wid = __builtin_amdgcn_readfirstlane(tid >> 6), lane = tid & 63, wr = wid >> 2, wc = wid & 3, fr = lane & 15, fq = lane >> 4;
  const int nt = K / 64;
  int R, C; stage_rc(tid * 16, R, C);
  const size_t offA = (size_t)R * lda + C, offB = (size_t)((R & ~31) + perm32(R & 31)) * ldb + C;
  const size_t a64 = (size_t)64 * lda, b64 = (size_t)64 * ldb, ah = (size_t)128 * lda, bh = (size_t)128 * ldb;
  const unsigned ldsw = (unsigned)wid * 1024u;
  const int aoff = lds_byte(wr * 64 + fr, fq * 8), boff = lds_byte(wc * 32 + fr, fq * 8);
#define G_SA(b, h) (((b) * 2 + (h)) * HT_B)
#define G_SB(b, h) ((4 + (b) * 2 + (h)) * HT_B)
#define G_STAGE(bufoff, gp, st64) do { const bf16_t* _g = (gp); \
    __builtin_amdgcn_global_load_lds((const unsigned*)_g, (LAS unsigned*)(lds + (bufoff) + ldsw), 16, 0, 0); \
    __builtin_amdgcn_global_load_lds((const unsigned*)(_g + (st64)), (LAS unsigned*)(lds + (bufoff) + ldsw + 8192), 16, 0, 0); } while (0)
#define G_LDA(dst, b, h) do { _Pragma("unroll") for (int m = 0; m < 4; ++m) _Pragma("unroll") for (int k = 0; k < 2; ++k) dst[m][k] = *(const LAS bf16x8*)(lds + G_SA(b, h) + aoff + m * 2048 + k * 1024); } while (0)
#define G_LDB(dst, b, h) do { _Pragma("unroll") for (int n = 0; n < 2; ++n) _Pragma("unroll") for (int k = 0; k < 2; ++k) dst[n][k] = *(const LAS bf16x8*)(lds + G_SB(b, h) + boff + n * 2048 + k * 1024); } while (0)
#define G_MMA(ai, bj, At, Bq) do { __builtin_amdgcn_s_setprio(1); _Pragma("unroll") for (int m = 0; m < 4; ++m) _Pragma("unroll") for (int n = 0; n < 2; ++n) _Pragma("unroll") for (int k = 0; k < 2; ++k) \
    acc[ai][bj][m][n] = __builtin_amdgcn_mfma_f32_16x16x32_bf16(Bq[n][k], At[m][k], acc[ai][bj][m][n], 0, 0, 0); __builtin_amdgcn_s_setprio(0); } while (0)
#define WAIT_V(n) asm volatile("s_waitcnt vmcnt(" #n ")" ::: "memory")
#define WAIT_L(n) asm volatile("s_waitcnt lgkmcnt(" #n ")" ::: "memory")
#define BAR __builtin_amdgcn_s_barrier()
#define SCHED __builtin_amdgcn_sched_barrier(0)
  UnitD cur, nxt; int ui = 0;
  if (!S.next(0, cur)) return;
  f32x4 acc[2][2][4][2];
#pragma unroll
  for (int a = 0; a < 2; ++a)
#pragma unroll
    for (int b = 0; b < 2; ++b)
#pragma unroll
      for (int m = 0; m < 4; ++m)
#pragma unroll
        for (int n = 0; n < 2; ++n) acc[a][b][m][n] = (f32x4){0.f, 0.f, 0.f, 0.f};
  bf16x8 At[4][2], B0[2][2], B1[2][2];
  const bf16_t* cA = cur.a + offA; const bf16_t* cB = cur.b + offB;
  G_STAGE(G_SB(0, 0), cB, b64); G_STAGE(G_SB(0, 1), cB + bh, b64); G_STAGE(G_SA(0, 0), cA, a64); G_STAGE(G_SA(0, 1), cA + ah, a64);
  if (wr == 1) BAR;
  WAIT_V(2); BAR;
  G_STAGE(G_SB(1, 0), cB + 64, b64); G_STAGE(G_SA(1, 0), cA + 64, a64); G_STAGE(G_SB(1, 1), cB + bh + 64, b64);
  WAIT_V(6); BAR;
  for (;;) {
    const bool has_next = S.next(ui + 1, nxt);
    const bf16_t* nA = has_next ? nxt.a + offA : cA; const bf16_t* nB = has_next ? nxt.b + offB : cB;
    for (int t = 0; t < nt; t += 2) {
      const bool last = (t == nt - 2);
      const bf16_t* a1 = cA + (size_t)(t + 1) * 64;
      const bf16_t* a2 = last ? nA : cA + (size_t)(t + 2) * 64; const bf16_t* b2 = last ? nB : cB + (size_t)(t + 2) * 64;
      const bf16_t* a3 = a2 + 64; const bf16_t* b3 = b2 + 64;
      const bool f0 = t < (nt >> 1);
      if (!HALFK || f0) G_LDB(B0, 0, 0); if (!HALFK || !f0) G_LDB(B1, 0, 1); SCHED; G_LDA(At, 0, 0); G_STAGE(G_SA(1, 1), a1 + ah, a64);
      WAIT_V(8); WAIT_L(0); BAR; if (!HALFK || f0) G_MMA(0, 0, At, B0); if (!HALFK || !f0) G_MMA(0, 1, At, B1); BAR; SCHED;
      G_LDA(At, 0, 1); G_STAGE(G_SB(0, 0), b2, b64); G_STAGE(G_SB(0, 1), b2 + bh, b64); G_STAGE(G_SA(0, 0), a2, a64);
      WAIT_V(8); WAIT_L(0); BAR; if (!HALFK || f0) G_MMA(1, 0, At, B0); if (!HALFK || !f0) G_MMA(1, 1, At, B1); BAR; SCHED;
      if (!HALFK || f0) G_LDB(B0, 1, 0); if (!HALFK || !f0) G_LDB(B1, 1, 1); SCHED; G_LDA(At, 1, 0); G_STAGE(G_SA(0, 1), a2 + ah, a64);
      WAIT_V(8); WAIT_L(0); BAR; if (!HALFK || f0) G_MMA(0, 0, At, B0); if (!HALFK || !f0) G_MMA(0, 1, At, B1); BAR; SCHED;
      G_LDA(At, 1, 1); G_STAGE(G_SB(1, 0), b3, b64); G_STAGE(G_SB(1, 1), b3 + bh, b64); G_STAGE(G_SA(1, 0), a3, a64);
      WAIT_V(8); WAIT_L(0); BAR; if (!HALFK || f0) G_MMA(1, 0, At, B0); if (!HALFK || !f0) G_MMA(1, 1, At, B1); BAR; SCHED;
    }
    if (wr == 0) BAR;
    epi(acc, cur.brow, cur.bcol, cur.aux, wr, wc, fr, fq);
    if (!has_next) break;
#pragma unroll
    for (int a = 0; a < 2; ++a)
#pragma unroll
      for (int b = 0; b < 2; ++b)
#pragma unroll
        for (int m = 0; m < 4; ++m)
#pragma unroll
          for (int n = 0; n < 2; ++n) acc[a][b][m][n] = (f32x4){0.f, 0.f, 0.f, 0.f};
    cur = nxt; cA = nA; cB = nB; ++ui;
    if (wr == 1) BAR;
  }
  WAIT_V(0);
  BAR;
}

#define EPI_ROWS _Pragma("unroll") for (int ai = 0; ai < 2; ++ai) _Pragma("unroll") for (int m = 0; m < 4; ++m)
DI float row_rs(const float* ps, int row) {
  const f32x4* q = (const f32x4*)(ps + (size_t)row * 16); const f32x4 a = q[0], b = q[1], c = q[2], d = q[3];
  const float s = ((a[0] + a[1]) + (a[2] + a[3])) + ((b[0] + b[1]) + (b[2] + b[3])) + ((c[0] + c[1]) + (c[2] + c[3])) + ((d[0] + d[1]) + (d[2] + d[3]));
  return 1.0f / sqrtf(s * (1.f / DM) + 1e-6f);
}
template <bool NORM> struct EpiGU {
  bf16_t* act; const float* ps; const float* shw;
  DI void operator()(EPI_ARGS) const {
    const int oc0 = (bcol >> 1) + wc * 32 + fq * 8;
    f32x4 sg0, sg1, su0, su1;
    if (NORM) { const float* sp = shw + (size_t)(brow >> 11) * 5632 + bcol + wc * 32 + fq * 8; sg0 = *(const f32x4*)sp; sg1 = *(const f32x4*)(sp + 4); su0 = *(const f32x4*)(sp + 128); su1 = *(const f32x4*)(sp + 132); }
    EPI_ROWS { const int row = brow + ai * 128 + wr * 64 + m * 16 + fr;
      f32x4 g0 = acc[ai][0][m][0], g1 = acc[ai][0][m][1], u0 = acc[ai][1][m][0], u1 = acc[ai][1][m][1];
      if (NORM) { const float rs = row_rs(ps, row); g0 = g0 * rs + sg0; g1 = g1 * rs + sg1; u0 = u0 * rs + su0; u1 = u1 * rs + su1; }
      u32x4 w; w.x = pk2(silu_(g0[0]) * u0[0], silu_(g0[1]) * u0[1]); w.y = pk2(silu_(g0[2]) * u0[2], silu_(g0[3]) * u0[3]);
      w.z = pk2(silu_(g1[0]) * u1[0], silu_(g1[1]) * u1[1]); w.w = pk2(silu_(g1[2]) * u1[2], silu_(g1[3]) * u1[3]);
      *(u32x4*)(act + (size_t)row * FF + oc0) = w; }
  }
};
struct EpiRes {
  const float* Hin; float* Hout; const float* gate; float coef;
  DI void operator()(EPI_ARGS) const {
    EPI_ROWS { const int row = brow + ai * 128 + wr * 64 + m * 16 + fr; const int b = row >> 11;
#pragma unroll
      for (int bj = 0; bj < 2; ++bj)
#pragma unroll
        for (int n = 0; n < 2; ++n) { const int col = bcol + bj * 128 + wc * 32 + fq * 8 + n * 4;
          const f32x4 hin = *(const f32x4*)(Hin + (size_t)row * DM + col); const f32x4 g4 = *(const f32x4*)(gate + b * MODW + col);
          *(f32x4*)(Hout + (size_t)row * DM + col) = hin + coef * g4 * acc[ai][bj][m][n]; } }
  }
};
template <bool HIN_BF16, bool WRITE_H, int COEF2> struct EpiResN {
  const void* Hin; bf16_t* Hout; const float* gate; const float* gtab; bf16_t* Un; float* ps;
  DI void operator()(EPI_ARGS) const {
    constexpr float coef = 0.5f * COEF2;
    EPI_ROWS { const int row = brow + ai * 128 + wr * 64 + m * 16 + fr; const int b = row >> 11; float ss = 0.f;
#pragma unroll
      for (int bj = 0; bj < 2; ++bj) { const int col = bcol + bj * 128 + wc * 32 + fq * 8; const size_t off = (size_t)row * DM + col;
        f32x4 x0, x1;
        if (HIN_BF16) { const u32x4 hw = *(const u32x4*)((const bf16_t*)Hin + off);
          x0[0] = bflo(hw.x); x0[1] = bfhi(hw.x); x0[2] = bflo(hw.y); x0[3] = bfhi(hw.y); x1[0] = bflo(hw.z); x1[1] = bfhi(hw.z); x1[2] = bflo(hw.w); x1[3] = bfhi(hw.w); }
        else { x0 = *(const f32x4*)((const float*)Hin + off); x1 = *(const f32x4*)((const float*)Hin + off + 4); }
        const f32x4 h0 = x0 + coef * *(const f32x4*)(gate + b * MODW + col) * acc[ai][bj][m][0];
        const f32x4 h1 = x1 + coef * *(const f32x4*)(gate + b * MODW + col + 4) * acc[ai][bj][m][1];
        if (WRITE_H) { u32x4 hv; hv.x = pk2(h0[0], h0[1]); hv.y = pk2(h0[2], h0[3]); hv.z = pk2(h1[0], h1[1]); hv.w = pk2(h1[2], h1[3]); *(u32x4*)(Hout + off) = hv; }
        const f32x4 a0 = h0 * *(const f32x4*)(gtab + b * DM + col), a1 = h1 * *(const f32x4*)(gtab + b * DM + col + 4);
        u32x4 w; w.x = pk2(a0[0], a0[1]); w.y = pk2(a0[2], a0[3]); w.z = pk2(a1[0], a1[1]); w.w = pk2(a1[2], a1[3]);
        *(u32x4*)(Un + off) = w;
        ss += ((h0[0] * h0[0] + h0[1] * h0[1]) + (h0[2] * h0[2] + h0[3] * h0[3])) + ((h1[0] * h1[0] + h1[1] * h1[1]) + (h1[2] * h1[2] + h1[3] * h1[3])); }
      ss += __shfl_xor(ss, 16); ss += __shfl_xor(ss, 32);
      if (fq == 0) ps[(size_t)row * 16 + (bcol >> 8) * 4 + wc] = ss; }
  }
};
struct EpiShW {
  float* out; int ldo;
  DI void operator()(EPI_ARGS) const {
    if (wr == 0) {
#pragma unroll
      for (int bj = 0; bj < 2; ++bj) { float* o = out + (size_t)fr * ldo + bcol + bj * 128 + wc * 32 + fq * 8;
        *(f32x4*)o = acc[0][bj][0][0]; *(f32x4*)(o + 4) = acc[0][bj][0][1]; }
    }
  }
};
struct OneUnit { const bf16_t* a; const bf16_t* b; int bcol;
  DI bool next(int i, UnitD& d) const { if (i > 0) return false; d.brow = 0; d.bcol = bcol; d.aux = 0; d.a = a; d.b = b; return true; } };
struct EpiProj {
  bf16_t* proj; bf16_t* kvc; const float* ps; const float* shw;
  DI void operator()(EPI_ARGS) const {
    f32x4 sw[2][2];
    { const float* sp = shw + (size_t)(brow >> 11) * LDP + bcol + wc * 32 + fq * 8; sw[0][0] = *(const f32x4*)sp; sw[0][1] = *(const f32x4*)(sp + 4); sw[1][0] = *(const f32x4*)(sp + 128); sw[1][1] = *(const f32x4*)(sp + 132); }
    EPI_ROWS { const int row = brow + ai * 128 + wr * 64 + m * 16 + fr; const float rs = row_rs(ps, row);
#pragma unroll
      for (int bj = 0; bj < 2; ++bj) { const int col = bcol + bj * 128 + wc * 32 + fq * 8; const f32x4 v0 = acc[ai][bj][m][0] * rs + sw[bj][0], v1 = acc[ai][bj][m][1] * rs + sw[bj][1];
        u32x4 w; w.x = pk2(v0[0], v0[1]); w.y = pk2(v0[2], v0[3]); w.z = pk2(v1[0], v1[1]); w.w = pk2(v1[2], v1[3]);
        *(u32x4*)(proj + (size_t)row * LDP + col) = w;
        if (bcol == 512) { const int c = col - 512, kv = c >> 7, g = (c >> 6) & 1, d = c & 63, b = row >> 11, s = row & 2047;
          *(u32x4*)(kvc + ((((size_t)kv * NB + b) * 2 + g) * SEQ + s) * 64 + d) = w; } } }
  }
};
struct EpiHid {
  bf16_t* hid; const float* bias;
  DI void operator()(EPI_ARGS) const {
    EPI_ROWS { const int row = brow + ai * 128 + wr * 64 + m * 16 + fr;
#pragma unroll
      for (int bj = 0; bj < 2; ++bj) { const int col = bcol + bj * 128 + wc * 32 + fq * 8;
        const f32x4 v0 = acc[ai][bj][m][0] + *(const f32x4*)(bias + col), v1 = acc[ai][bj][m][1] + *(const f32x4*)(bias + col + 4);
        u32x4 w; w.x = pk2(gelu_tanh(v0[0]), gelu_tanh(v0[1])); w.y = pk2(gelu_tanh(v0[2]), gelu_tanh(v0[3])); w.z = pk2(gelu_tanh(v1[0]), gelu_tanh(v1[1])); w.w = pk2(gelu_tanh(v1[2]), gelu_tanh(v1[3]));
        *(u32x4*)(hid + (size_t)row * 256 + col) = w; } }
  }
};
struct EpiUp {
  bf16_t* proj; bf16_t* merged;
  DI void operator()(EPI_ARGS) const {
    EPI_ROWS { const int row = brow + ai * 128 + wr * 64 + m * 16 + fr; bf16_t* pr = proj + (size_t)row * LDP;
#pragma unroll
      for (int bj = 0; bj < 2; ++bj) { const int col = bcol + bj * 128 + wc * 32 + fq * 8; const f32x4 v0 = acc[ai][bj][m][0], v1 = acc[ai][bj][m][1];
        const u32x4 gw = *(const u32x4*)(pr + 2048 + aux * 1024 + col);
        f32x4 o0, o1; o0[0] = sigm(bflo(gw.x)) * v0[0]; o0[1] = sigm(bfhi(gw.x)) * v0[1]; o0[2] = sigm(bflo(gw.y)) * v0[2]; o0[3] = sigm(bfhi(gw.y)) * v0[3];
        o1[0] = sigm(bflo(gw.z)) * v1[0]; o1[1] = sigm(bfhi(gw.z)) * v1[1]; o1[2] = sigm(bflo(gw.w)) * v1[2]; o1[3] = sigm(bfhi(gw.w)) * v1[3];
        bf16_t* tp = pr + col;
        if (aux == 0) { u32x4 w; w.x = pk2(o0[0], o0[1]); w.y = pk2(o0[2], o0[3]); w.z = pk2(o1[0], o1[1]); w.w = pk2(o1[2], o1[3]); *(u32x4*)tp = w; }
        else { const u32x4 tw = *(const u32x4*)tp;
          f32x4 t0, t1; t0[0] = bflo(tw.x) + o0[0]; t0[1] = bfhi(tw.x) + o0[1]; t0[2] = bflo(tw.y) + o0[2]; t0[3] = bfhi(tw.y) + o0[3];
          t1[0] = bflo(tw.z) + o1[0]; t1[1] = bfhi(tw.z) + o1[1]; t1[2] = bflo(tw.w) + o1[2]; t1[3] = bfhi(tw.w) + o1[3];
          u32x4 w; w.x = pk2(t0[0], t0[1]); w.y = pk2(t0[2], t0[3]); w.z = pk2(t1[0], t1[1]); w.w = pk2(t1[2], t1[3]);
          *(u32x4*)(merged + (size_t)row * DM + col) = w; } } }
  }
};
struct EpiUp2 {
  const bf16_t* proj; bf16_t* merged;
  DI void operator()(EPI_ARGS) const {
    const int oc = (bcol >> 1) + wc * 32 + fq * 8;
    EPI_ROWS { const int row = brow + ai * 128 + wr * 64 + m * 16 + fr; const bf16_t* pr = proj + (size_t)row * LDP;
      const u32x4 ga = *(const u32x4*)(pr + 2048 + oc), gb = *(const u32x4*)(pr + 3072 + oc);
      const f32x4 a0 = acc[ai][0][m][0], a1 = acc[ai][0][m][1], b0 = acc[ai][1][m][0], b1 = acc[ai][1][m][1];
      u32x4 w;
      w.x = pk2(sigm(bflo(ga.x)) * a0[0] + sigm(bflo(gb.x)) * b0[0], sigm(bfhi(ga.x)) * a0[1] + sigm(bfhi(gb.x)) * b0[1]);
      w.y = pk2(sigm(bflo(ga.y)) * a0[2] + sigm(bflo(gb.y)) * b0[2], sigm(bfhi(ga.y)) * a0[3] + sigm(bfhi(gb.y)) * b0[3]);
      w.z = pk2(sigm(bflo(ga.z)) * a1[0] + sigm(bflo(gb.z)) * b1[0], sigm(bfhi(ga.z)) * a1[1] + sigm(bfhi(gb.z)) * b1[1]);
      w.w = pk2(sigm(bflo(ga.w)) * a1[2] + sigm(bflo(gb.w)) * b1[2], sigm(bfhi(ga.w)) * a1[3] + sigm(bfhi(gb.w)) * b1[3]);
      *(u32x4*)(merged + (size_t)row * DM + oc) = w; }
  }
};
struct UpUnits { const bf16_t* ya; const bf16_t* yb; const bf16_t* wa; const bf16_t* wb;
  DI bool next(int i, UnitD& d) const { int pm, pn; if (!unit_of((i >> 1) * (int)gridDim.x + (int)blockIdx.x, 128, 4, pm, pn)) return false;
    d.brow = pm * 256; d.bcol = pn * 256; d.aux = i & 1; d.a = ((i & 1) ? yb : ya) + (size_t)d.brow * 512; d.b = ((i & 1) ? wb : wa) + (size_t)d.bcol * 512; return true; } };
struct CmpUnits { const bf16_t* kvc; const bf16_t* w1t;
  DI bool next(int i, UnitD& d) const { if (i > 0 || blockIdx.x >= 32) return false; const int kv = blockIdx.x >> 4, pm = blockIdx.x & 15;
    d.brow = pm * 256; d.bcol = 0; d.aux = kv; d.a = kvc + (size_t)kv * SZ_KVC1 + (size_t)d.brow * 1024; d.b = w1t + (size_t)kv * 256 * 2048; return true; } };
struct EpiHid2 { bf16_t* hid; const float* cb;
  DI void operator()(EPI_ARGS) const { EpiHid{hid + (size_t)aux * 4096 * 256, cb + aux * 256}(acc, brow, bcol, aux, wr, wc, fr, fq); } };

constexpr int VST = 192;
constexpr int AL_SLOT = 9216 + 64 * VST;
constexpr int AL_IA = 2 * AL_SLOT, AL_IB = AL_IA + 4 * 64 * 33 * 4, AL_SEL = AL_IB + 4 * 64 * 33 * 4, AL_UNI = AL_SEL + 256;
#define MFMA32(a, b, c) __builtin_amdgcn_mfma_f32_32x32x16_bf16((a), (b), (c), 0, 0, 0)

struct TileP { int j; int lim_hi, lim_lo; float rowbias; };

DI void tile_scores(const int slot, const bf16x8 (&qf)[4], f32x16& s0, f32x16& s1, LAS unsigned char* lds) {
  const int lane = otid() & 63, r = lane & 31, h = lane >> 5;
#pragma unroll
  for (int i = 0; i < 16; ++i) { s0[i] = 0.f; s1[i] = 0.f; }
  LAS unsigned char* kl = lds + slot * AL_SLOT + r * 144 + h * 16;
#pragma unroll
  for (int ks = 0; ks < 4; ++ks) {
    const bf16x8 k0 = *(const LAS bf16x8*)(kl + ks * 32);
    const bf16x8 k1 = *(const LAS bf16x8*)(kl + 32 * 144 + ks * 32);
    s0 = MFMA32(k0, qf[ks], s0);
    s1 = MFMA32(k1, qf[ks], s1);
  }
}
template <int MODE, bool MASKED>
DI void tile_softmax(const TileP& tp, f32x16& s0, f32x16& s1, const float slope2, const int t, f32x16 (&o)[2], float& m, float& l, float (&G)[8], float (&Lr)[8]) {
  const int lane = threadIdx.x & 63, h = lane >> 5;
  float base, cstep;
  if (MODE == 0) { base = slope2 * (float)(16 * (tp.j * 64 + 4 * h) + 31 - t); cstep = 16.f * slope2; }
  else { base = slope2 * (float)(tp.j * 64 + 4 * h - t) + tp.rowbias; cstep = slope2; }
  float tm = -1e30f;
#pragma unroll
  for (int i = 0; i < 16; ++i) {
    const int c0 = 8 * (i >> 2) + (i & 3), c1 = 32 + c0;
    float v0 = __builtin_fmaf(s0[i], C1, __builtin_fmaf(cstep, (float)c0, base));
    float v1 = __builtin_fmaf(s1[i], C1, __builtin_fmaf(cstep, (float)c1, base));
    if (MASKED) { v0 = (c0 <= tp.lim_hi && c0 >= tp.lim_lo) ? v0 : -1e30f; v1 = (c1 <= tp.lim_hi && c1 >= tp.lim_lo) ? v1 : -1e30f; }
    s0[i] = v0; s1[i] = v1; tm = fmaxf(tm, fmaxf(v0, v1));
  }
  tm = fmaxf(tm, __shfl_xor(tm, 32));
  const float mn = fmaxf(m, tm), alpha = fexp2(m - mn); m = mn;
  float ls = 0.f;
#pragma unroll
  for (int i = 0; i < 16; ++i) { const float p0 = fexp2(s0[i] - mn), p1 = fexp2(s1[i] - mn); s0[i] = p0; s1[i] = p1; ls += p0 + p1; }
  l = l * alpha + ls;
#pragma unroll
  for (int i = 0; i < 16; ++i) { o[0][i] *= alpha; o[1][i] *= alpha; }
  if (MODE == 0) {
#pragma unroll
    for (int g4 = 0; g4 < 4; ++g4) {
      G[g4] = (s0[4 * g4] + s0[4 * g4 + 1]) + (s0[4 * g4 + 2] + s0[4 * g4 + 3]); Lr[g4] = s0[4 * g4 + 3];
      G[4 + g4] = (s1[4 * g4] + s1[4 * g4 + 1]) + (s1[4 * g4 + 2] + s1[4 * g4 + 3]); Lr[4 + g4] = s1[4 * g4 + 3];
    }
  }
}
DI void tile_pv(const int slot, const f32x16& s0, const f32x16& s1, f32x16 (&o)[2], LAS unsigned char* lds) {
  const int lane = otid() & 63, h = lane >> 5;
  const int i16 = lane & 15, q4 = i16 >> 2, p4 = i16 & 3, blk = (lane >> 4) & 1;
  LAS unsigned char* vl = lds + slot * AL_SLOT + 9216 + (4 * h + q4) * VST + blk * 32 + 8 * p4;
#pragma unroll
  for (int kb = 0; kb < 2; ++kb)
#pragma unroll
    for (int sp = 0; sp < 2; ++sp) {
      u32x4 pw;
      if (kb == 0) { pw.x = pk2(s0[8 * sp], s0[8 * sp + 1]); pw.y = pk2(s0[8 * sp + 2], s0[8 * sp + 3]); pw.z = pk2(s0[8 * sp + 4], s0[8 * sp + 5]); pw.w = pk2(s0[8 * sp + 6], s0[8 * sp + 7]); }
      else { pw.x = pk2(s1[8 * sp], s1[8 * sp + 1]); pw.y = pk2(s1[8 * sp + 2], s1[8 * sp + 3]); pw.z = pk2(s1[8 * sp + 4], s1[8 * sp + 5]); pw.w = pk2(s1[8 * sp + 6], s1[8 * sp + 7]); }
      const bf16x8 pf = __builtin_bit_cast(bf16x8, pw);
      LAS unsigned char* vb = vl + (kb * 32 + 16 * sp) * VST;
#pragma unroll
      for (int db = 0; db < 2; ++db) {
        const s16x4 lo = __builtin_amdgcn_ds_read_tr16_b64_v4i16((LAS s16x4*)(vb + db * 64));
        const s16x4 hi = __builtin_amdgcn_ds_read_tr16_b64_v4i16((LAS s16x4*)(vb + db * 64 + 8 * VST));
        const bf16x8 vf = __builtin_shufflevector(lo, hi, 0, 1, 2, 3, 4, 5, 6, 7);
        o[db] = MFMA32(vf, pf, o[db]);
      }
    }
}
template <int MODE, bool MA, bool MB>
DI void pair_compute(const TileP& ta, const TileP& tb, const bf16x8 (&qf)[4], const float slope2, const int t, f32x16 (&o)[2], float& m, float& l,
                     float (&GA)[8], float (&LA)[8], float (&GB)[8], float (&LB)[8], float& m_after_a, LAS unsigned char* lds) {
  const bool early = (MODE != 0) && ((threadIdx.x >> 8) & 1) != 0;
  f32x16 a0, a1, b0, b1;
  tile_scores(0, qf, a0, a1, lds);
  if (early) tile_scores(1, qf, b0, b1, lds);
  __builtin_amdgcn_sched_barrier(0);
  tile_softmax<MODE, MA>(ta, a0, a1, slope2, t, o, m, l, GA, LA);
  m_after_a = m;
  __builtin_amdgcn_sched_barrier(0);
  tile_pv(0, a0, a1, o, lds);
  __builtin_amdgcn_sched_barrier(0);
  if (!early) tile_scores(1, qf, b0, b1, lds);
  __builtin_amdgcn_sched_barrier(0);
  tile_softmax<MODE, MB>(tb, b0, b1, slope2, t, o, m, l, GB, LB);
  __builtin_amdgcn_sched_barrier(0);
  tile_pv(1, b0, b1, o, lds);
}
template <int MODE, bool MA>
DI void single_compute(const TileP& ta, const bf16x8 (&qf)[4], const float slope2, const int t, f32x16 (&o)[2], float& m, float& l, LAS unsigned char* lds) {
  f32x16 a0, a1; float Gd[8], Ld[8];
  tile_scores(0, qf, a0, a1, lds);
  tile_softmax<MODE, MA>(ta, a0, a1, slope2, t, o, m, l, Gd, Ld);
  tile_pv(0, a0, a1, o, lds);
}
struct StageRegs { u32x4 k0, v0, k1, v1; };
DI void stage_load(StageRegs& sr, const bf16_t* Kp, const bf16_t* Vp, const int stride, const int ja, const int jb) {
  const int tid = otid(), srow = tid >> 3, sch = tid & 7;
  sr.k0 = *(const u32x4*)(Kp + (size_t)(ja * 64 + srow) * stride + sch * 8);
  sr.v0 = *(const u32x4*)(Vp + (size_t)(ja * 64 + srow) * stride + sch * 8);
  sr.k1 = *(const u32x4*)(Kp + (size_t)(jb * 64 + srow) * stride + sch * 8);
  sr.v1 = *(const u32x4*)(Vp + (size_t)(jb * 64 + srow) * stride + sch * 8);
}
DI void stage_store(const StageRegs& sr, LAS unsigned char* lds) {
  const int tid = otid(), srow = tid >> 3, sch = tid & 7;
  LAS unsigned char* d = lds + srow * 144 + sch * 16; LAS unsigned char* dv = lds + 9216 + srow * VST + sch * 16;
  *(LAS u32x4*)(d) = sr.k0; *(LAS u32x4*)(dv) = sr.v0; *(LAS u32x4*)(d + AL_SLOT) = sr.k1; *(LAS u32x4*)(dv + AL_SLOT) = sr.v1;
}

template <int MODE>
DI void attn_branch(unsigned tilemask, const bf16_t* Kp, const bf16_t* Vp, const int stride, const bf16x8 (&qf)[4], const float slope2, const int t, const int cur,
                    const unsigned mysel, f32x16 (&o)[2], float& m, float& l, LAS unsigned char* lds) {
  const int lane = threadIdx.x & 63, h = lane >> 5;
  float GA[8], LA[8], GB[8], LB[8], mdum;
  StageRegs sr;
  { const int ja = __builtin_ctz(tilemask); const unsigned rest = tilemask & (tilemask - 1); const int jb = rest ? __builtin_ctz(rest) : ja;
    stage_load(sr, Kp, Vp, stride, ja, jb); }
  while (tilemask) {
    const int ja = __builtin_ctz(tilemask); tilemask &= tilemask - 1;
    const bool hasb = tilemask != 0; const int jb = hasb ? __builtin_ctz(tilemask) : ja; if (hasb) tilemask &= tilemask - 1;
    __syncthreads();
    stage_store(sr, lds);
    __syncthreads();
    if (tilemask) { const int na = __builtin_ctz(tilemask); const unsigned rest = tilemask & (tilemask - 1); const int nb = rest ? __builtin_ctz(rest) : na;
      stage_load(sr, Kp, Vp, stride, na, nb); }
    TileP ta, tb; bool ma = false, mb = false;
    { const int rel = t - ja * 64 - 4 * h; ta.j = ja; ta.lim_hi = 1000; ta.lim_lo = -100000; ta.rowbias = 0.f;
      if (ja == cur) { ta.lim_hi = rel; ma = true; }
      if (MODE == 1 && !((mysel >> ja) & 1u)) ta.rowbias = -1e30f;
      if (MODE == 2 && ja == cur - 8) { ta.lim_lo = rel - 511; ma = true; }
      if (MODE == 3 && ja == cur - 2) { ta.lim_lo = rel - 127; ma = true; } }
    { const int rel = t - jb * 64 - 4 * h; tb.j = jb; tb.lim_hi = 1000; tb.lim_lo = -100000; tb.rowbias = 0.f;
      if (jb == cur) { tb.lim_hi = rel; mb = true; }
      if (MODE == 1 && !((mysel >> jb) & 1u)) tb.rowbias = -1e30f;
      if (MODE == 2 && jb == cur - 8) { tb.lim_lo = rel - 511; mb = true; }
      if (MODE == 3 && jb == cur - 2) { tb.lim_lo = rel - 127; mb = true; } }
    if (hasb) {
      if (ma) { if (mb) pair_compute<MODE, true, true>(ta, tb, qf, slope2, t, o, m, l, GA, LA, GB, LB, mdum, lds);
                else pair_compute<MODE, true, false>(ta, tb, qf, slope2, t, o, m, l, GA, LA, GB, LB, mdum, lds); }
      else { if (mb) pair_compute<MODE, false, true>(ta, tb, qf, slope2, t, o, m, l, GA, LA, GB, LB, mdum, lds);
             else pair_compute<MODE, false, false>(ta, tb, qf, slope2, t, o, m, l, GA, LA, GB, LB, mdum, lds); }
    } else {
      if (ma) single_compute<MODE, true>(ta, qf, slope2, t, o, m, l, lds);
      else single_compute<MODE, false>(ta, qf, slope2, t, o, m, l, lds);
    }
  }
}

DI void zero_o(f32x16 (&o)[2]) {
#pragma unroll
  for (int i = 0; i < 16; ++i) { o[0][i] = 0.f; o[1][i] = 0.f; }
}
template <int STEP>
DI void y_step(f32x16 (&o)[2], const float sc, LAS unsigned char* lds) {
  const int tid = threadIdx.x, wid = tid >> 6, lane = tid & 63;
  LAS f32x4* yb = (LAS f32x4*)(lds + AL_IA) + (wid * 8) * 64 + lane;
#pragma unroll
  for (int db = 0; db < 2; ++db)
#pragma unroll
    for (int g4 = 0; g4 < 4; ++g4) {
      f32x4 v = {sc * o[db][4 * g4], sc * o[db][4 * g4 + 1], sc * o[db][4 * g4 + 2], sc * o[db][4 * g4 + 3]};
      LAS f32x4* s = yb + (db * 4 + g4) * 64;
      if (STEP >= 1) v = v + *s;
      if (STEP <= 1) *s = v;
      else { o[db][4 * g4] = v[0]; o[db][4 * g4 + 1] = v[1]; o[db][4 * g4 + 2] = v[2]; o[db][4 * g4 + 3] = v[3]; }
    }
}
DI void store_y(bf16_t* yrow, const f32x16 (&y)[2], int h) {
#pragma unroll
  for (int db = 0; db < 2; ++db)
#pragma unroll
    for (int g4 = 0; g4 < 4; ++g4) { u32x2 w; w.x = pk2(y[db][4 * g4], y[db][4 * g4 + 1]); w.y = pk2(y[db][4 * g4 + 2], y[db][4 * g4 + 3]);
      *(u32x2*)(yrow + db * 32 + 8 * g4 + 4 * h) = w; }
}

DI void swa_unit(const Params& p, int unit, LAS unsigned char* lds) {
  const int qt = unit & 31, g = (unit >> 5) & 1, b = unit >> 6;
  const int tid = threadIdx.x, wid = tid >> 6, lane = tid & 63, r = lane & 31, h = lane >> 5;
  const int hh = g * 4 + (wid >> 1), t = qt * 64 + (wid & 1) * 32 + r; const size_t row = (size_t)b * SEQ + t;
  const bf16_t* proj = (const bf16_t*)(p.ws + OFF_ACT);
  const float slope2 = fexp2(-(float)(hh + 1)) * LOG2E;
  bf16x8 qf[4];
  { const bf16_t* qp = proj + row * LDP + 1280 + hh * 64 + h * 8;
#pragma unroll
    for (int ks = 0; ks < 4; ++ks) qf[ks] = *(const bf16x8*)(qp + ks * 16); }
  f32x16 o[2]; zero_o(o); float m = -1e4f, l = 0.f;
  const int jlo = qt >= 2 ? qt - 2 : 0;
  const unsigned tmask = ((2u << qt) - 1u) & ~((1u << jlo) - 1u);
  const bf16_t* kvb = proj + (size_t)b * SEQ * LDP;
  attn_branch<3>(tmask, kvb + 1792 + g * 64, kvb + 1920 + g * 64, LDP, qf, slope2, t, qt, 0u, o, m, l, lds);
  float lt = l + __shfl_xor(l, 32);
  lt += fexp2(p.in[16][hh] * LOG2E - m);
  const float inv = frcp(lt);
#pragma unroll
  for (int i = 0; i < 16; ++i) { o[0][i] *= inv; o[1][i] *= inv; }
  store_y((bf16_t*)(p.ws + OFF_YA) + row * 1024 + 512 + hh * 64, o, h);
  __syncthreads();
}

DI void nsa_unit(const Params& p, int unit, LAS unsigned char* lds) {
  const int qt = unit & 31, g = (unit >> 5) & 1, b = unit >> 6;
  const int tid = threadIdx.x, wid = tid >> 6, lane = tid & 63, r = lane & 31, h = lane >> 5;
  const int hr = wid >> 1, qloc = (wid & 1) * 32 + r, hh = g * 4 + hr, t = qt * 64 + qloc; const size_t row = (size_t)b * SEQ + t;
  const bf16_t* proj = (const bf16_t*)(p.ws + OFF_ACT);
  const float slope2 = fexp2(-(float)(hh + 1)) * LOG2E;
  bf16x8 qf[4];
  { const bf16_t* qp = proj + row * LDP + hh * 64 + h * 8;
#pragma unroll
    for (int ks = 0; ks < 4; ++ks) qf[ks] = *(const bf16x8*)(qp + ks * 16); }
  float gt0, gt1, gt2;
  { const bf16_t* gp = proj + row * LDP + 4096 + hh * 3; gt0 = sigm(bf2f(gp[0])); gt1 = sigm(bf2f(gp[1])); gt2 = sigm(bf2f(gp[2])); }
  if (tid == 0) *(LAS unsigned*)(lds + AL_UNI) = 0u;
  f32x16 o[2];
  float sc_cmp;
  {
    zero_o(o); float m = -1e4f, l = 0.f;
    const bf16_t* kc = (const bf16_t*)(p.ws + OFF_KC) + (size_t)(b * 2 + g) * 128 * 64;
    const bf16_t* vc = kc + (size_t)4096 * 64;
    const int nmax = t >= 31 ? ((t - 31) >> 4) : -1;
    float G0[8], L0[8], G1[8], L1[8], m0;
    StageRegs sr; stage_load(sr, kc, vc, 64, 0, 1);
    __syncthreads();
    stage_store(sr, lds);
    __syncthreads();
    TileP ta, tb; ta.j = 0; ta.lim_hi = nmax - 4 * h; ta.lim_lo = -100000; ta.rowbias = 0.f; tb.j = 1; tb.lim_hi = nmax - 64 - 4 * h; tb.lim_lo = -100000; tb.rowbias = 0.f;
    pair_compute<0, true, true>(ta, tb, qf, slope2, t, o, m, l, G0, L0, G1, L1, m0, lds);
    const float lt = l + __shfl_xor(l, 32);
    const float inv = lt > 0.f ? frcp(lt) : 0.f;
    const float f0 = fexp2(m0 - m) * inv, f1 = inv;
    LAS float* ia = (LAS float*)(lds + AL_IA) + (hr * 64 + qloc) * 33;
    LAS float* ib = (LAS float*)(lds + AL_IB) + (hr * 64 + qloc) * 33;
#pragma unroll
    for (int kb = 0; kb < 2; ++kb)
#pragma unroll
      for (int g4 = 0; g4 < 4; ++g4) {
        const int j0 = kb * 8 + 2 * g4 + h, j1 = 16 + j0;
        ia[j0] = G0[kb * 4 + g4] * f0; ib[j0 + 1] = L0[kb * 4 + g4] * f0;
        ia[j1] = G1[kb * 4 + g4] * f1; if (j1 < 31) ib[j1 + 1] = L1[kb * 4 + g4] * f1;
      }
    sc_cmp = gt0 * inv;
  }
  __syncthreads();
  {
    const int cur = qt, q = tid >> 3, part = tid & 7; unsigned mask;
    if (cur <= 7) mask = (2u << cur) - 1u;
    else {
      LAS float* ia = (LAS float*)(lds + AL_IA) + q * 33;
      LAS float* ib = (LAS float*)(lds + AL_IB) + q * 33;
      float v[4];
#pragma unroll
      for (int i = 0; i < 4; ++i) { const int j = part + 8 * i; float s = -2.f;
        if (j >= 1 && j <= cur - 2) { s = 0.f;
#pragma unroll
          for (int hd = 0; hd < 4; ++hd) s += ia[hd * 64 * 33 + j] + ib[hd * 64 * 33 + j]; }
        v[i] = s; }
      mask = 1u | (1u << cur) | (1u << (cur - 1));
#pragma unroll
      for (int k = 0; k < 5; ++k) {
        float best = v[0]; int bi = part;
#pragma unroll
        for (int i = 1; i < 4; ++i) if (v[i] > best) { best = v[i]; bi = part + 8 * i; }
#pragma unroll
        for (int sh = 1; sh < 8; sh <<= 1) { const float ob = __shfl_xor(best, sh); const int oi = __shfl_xor(bi, sh);
          if (ob > best || (ob == best && oi < bi)) { best = ob; bi = oi; } }
        mask |= 1u << bi;
#pragma unroll
        for (int i = 0; i < 4; ++i) if (bi == part + 8 * i) v[i] = -2.f;
      }
    }
    if (part == 0) { *((LAS unsigned*)(lds + AL_SEL) + q) = mask; atomicOr((unsigned*)(LAS unsigned*)(lds + AL_UNI), mask); }
  }
  __syncthreads();
  const unsigned mysel = *((LAS unsigned*)(lds + AL_SEL) + qloc);
  const unsigned uni = *(LAS unsigned*)(lds + AL_UNI);
  const bf16_t* kvb = proj + (size_t)b * SEQ * LDP;
  __syncthreads();
  y_step<0>(o, sc_cmp, lds);
  {
    zero_o(o); float m = -1e4f, l = 0.f;
    attn_branch<1>(uni & ((2u << qt) - 1u), kvb + 768 + g * 64, kvb + 896 + g * 64, LDP, qf, slope2, t, qt, mysel, o, m, l, lds);
    const float lt = l + __shfl_xor(l, 32); const float sc = gt1 * (lt > 0.f ? frcp(lt) : 0.f);
    y_step<1>(o, sc, lds);
  }
  {
    zero_o(o); float m = -1e4f, l = 0.f;
    const int jlo = qt >= 8 ? qt - 8 : 0;
    attn_branch<2>(((2u << qt) - 1u) & ~((1u << jlo) - 1u), kvb + 1024 + g * 64, kvb + 1152 + g * 64, LDP, qf, slope2, t, qt, 0u, o, m, l, lds);
    const float lt = l + __shfl_xor(l, 32); const float sc = gt2 * (lt > 0.f ? frcp(lt) : 0.f);
    y_step<2>(o, sc, lds);
  }
  store_y((bf16_t*)(p.ws + OFF_YA) + row * 1024 + hh * 64, o, h);
  __syncthreads();
}

DI int rowmap(int n, int mode) {
  if (mode == 0) return n;
  if (mode == 1) return (n >> 7) * 256 + (n & 127);
  if (mode == 2) return (n >> 7) * 256 + 128 + (n & 127);
  return n < 1280 ? n : (n < 1304 ? 4096 + (n - 1280) : n - 24);
}
struct TrItem { const float* W; bf16_t* WT; int K, N, mode, k0, n0, ldk, koff; };
constexpr int TR_LD = 261;
DI void tr_load(const TrItem& it, f32x4 (&v)[8]) {
  const int tid = otid(), c4 = (tid & 63) * 4, kr = tid >> 6;
#pragma unroll
  for (int i = 0; i < 8; ++i) { const int kk = kr + 8 * i;
    v[i] = (it.n0 + c4 < it.N) ? *(const f32x4*)(it.W + (size_t)(it.k0 + kk) * it.N + it.n0 + c4) : (f32x4){0.f, 0.f, 0.f, 0.f}; }
}
DI void tr_to_lds(const f32x4 (&v)[8], LAS unsigned char* lds) {
  const int tid = otid(), c4 = (tid & 63) * 4, kr = tid >> 6; LAS float* tile = (LAS float*)lds;
#pragma unroll
  for (int i = 0; i < 8; ++i) { LAS float* d = tile + (kr + 8 * i) * TR_LD + c4; d[0] = v[i][0]; d[1] = v[i][1]; d[2] = v[i][2]; d[3] = v[i][3]; }
}
DI void tr_store(const TrItem& it, LAS unsigned char* lds) {
  const int tid = otid(); LAS float* tile = (LAS float*)lds;
  const int ch = tid & 7;
#pragma unroll
  for (int i = 0; i < 4; ++i) { const int nn = (tid >> 3) + 64 * i; LAS float* s = tile + (ch * 8) * TR_LD + nn;
    u32x4 w; w.x = pk2(s[0], s[TR_LD]); w.y = pk2(s[2 * TR_LD], s[3 * TR_LD]); w.z = pk2(s[4 * TR_LD], s[5 * TR_LD]); w.w = pk2(s[6 * TR_LD], s[7 * TR_LD]);
    if (it.n0 + nn < it.N) *(u32x4*)(it.WT + (size_t)rowmap(it.n0 + nn, it.mode) * it.ldk + it.koff + it.k0 + ch * 8) = w; }
}
DI void mod_item(const Params& p, int item, LAS unsigned char* lds) {
  const int tid = threadIdx.x, n0 = item * 64, kq = tid >> 6, nn = tid & 63;
  LAS float* sc = (LAS float*)lds;
  LAS float* red = (LAS float*)(lds + 65536);
  for (int e = tid; e < NB * DM; e += 512) sc[e] = silu_(p.in[1][e]);
  __syncthreads();
  float acc[16];
#pragma unroll
  for (int b = 0; b < 16; ++b) acc[b] = 0.f;
  const float* w = p.in[2] + (size_t)(kq * 128) * MODW + n0 + nn;
  for (int k = 0; k < 128; k += 4) { const float w0 = w[(size_t)k * MODW], w1 = w[(size_t)(k + 1) * MODW], w2 = w[(size_t)(k + 2) * MODW], w3 = w[(size_t)(k + 3) * MODW];
#pragma unroll
    for (int b = 0; b < 16; ++b) { const f32x4 s4 = *(const LAS f32x4*)(sc + b * DM + kq * 128 + k);
      acc[b] = __builtin_fmaf(s4[0], w0, acc[b]); acc[b] = __builtin_fmaf(s4[1], w1, acc[b]); acc[b] = __builtin_fmaf(s4[2], w2, acc[b]); acc[b] = __builtin_fmaf(s4[3], w3, acc[b]); } }
#pragma unroll
  for (int b = 0; b < 16; ++b) red[(kq * 16 + b) * 64 + nn] = acc[b];
  __syncthreads();
  float* mod = (float*)(p.ws + OFF_MOD);
  for (int e = tid; e < 1024; e += 512) { const int b = e >> 6, n = e & 63; float s = p.in[3][n0 + n];
#pragma unroll
    for (int q = 0; q < 8; ++q) s += red[(q * 16 + b) * 64 + n];
    mod[b * MODW + n0 + n] = s; }
  __syncthreads();
}
DI void phase0(const Params& p, LAS unsigned char* lds) {
  const int tid = otid(), bid = blockIdx.x, G = gridDim.x;
  for (int it = bid; it < 144; it += G) mod_item(p, it, lds);
  bf16_t* wgu1 = (bf16_t*)(p.ws + OFF_WGU1); bf16_t* wd1 = (bf16_t*)(p.ws + OFF_WD1); bf16_t* wgu2 = (bf16_t*)(p.ws + OFF_WGU2); bf16_t* wd2 = (bf16_t*)(p.ws + OFF_WD2);
  bf16_t* win = (bf16_t*)(p.ws + OFF_WIN); bf16_t* wup = (bf16_t*)(p.ws + OFF_WUP); bf16_t* wout = (bf16_t*)(p.ws + OFF_WOUT);
  bf16_t* w1t = (bf16_t*)(p.ws + OFF_W1T);
  constexpr int I_G = 16 * 11, I_D = 44 * 4, I_IN = 16 * 17, I_UP = 8 * 4, I_OUT = 16 * 4, I_C = 32 * 1;
  constexpr int NIT = 4 * I_G + 2 * I_D + I_IN + 2 * I_UP + I_OUT + 2 * I_C;
  auto decode = [&](int it, TrItem& d) {
    int r = it; const float* W; bf16_t* WT; int K, N, mode, ldk = 0, koff = 0;
    if (r < I_G) { W = p.in[5]; K = 1024; N = FF; WT = wgu1; mode = 1; }
    else if ((r -= I_G) < I_G) { W = p.in[6]; K = 1024; N = FF; WT = wgu1; mode = 2; }
    else if ((r -= I_G) < I_D) { W = p.in[7]; K = FF; N = 1024; WT = wd1; mode = 0; }
    else if ((r -= I_D) < I_G) { W = p.in[21]; K = 1024; N = FF; WT = wgu2; mode = 1; }
    else if ((r -= I_G) < I_G) { W = p.in[22]; K = 1024; N = FF; WT = wgu2; mode = 2; }
    else if ((r -= I_G) < I_D) { W = p.in[23]; K = FF; N = 1024; WT = wd2; mode = 0; }
    else if ((r -= I_D) < I_IN) { W = p.in[9]; K = 1024; N = INW; WT = win; mode = 3; }
    else if ((r -= I_IN) < I_UP) { W = p.in[17]; K = 512; N = 1024; WT = wup; mode = 1; ldk = 1024; }
    else if ((r -= I_UP) < I_UP) { W = p.in[18]; K = 512; N = 1024; WT = wup; mode = 2; ldk = 1024; koff = 512; }
    else if ((r -= I_UP) < I_OUT) { W = p.in[19]; K = 1024; N = 1024; WT = wout; mode = 0; }
    else if ((r -= I_OUT) < I_C) { W = p.in[11]; K = 2048; N = 256; WT = w1t; mode = 0; }
    else { r -= I_C; W = p.in[14]; K = 2048; N = 256; WT = w1t + (size_t)256 * 2048; mode = 0; }
    const int ntn = (N + 255) >> 8;
    d.W = W; d.WT = WT; d.K = K; d.N = N; d.mode = mode; d.ldk = ldk ? ldk : K; d.koff = koff; d.k0 = (r / ntn) * 64; d.n0 = (r % ntn) * 256;
  };
  {
    f32x4 v[8]; TrItem cur, nxt;
    int it = bid;
    if (it < NIT) { decode(it, cur); tr_load(cur, v); }
    while (it < NIT) {
      tr_to_lds(v, lds);
      __syncthreads();
      const int itn = it + G;
      if (itn < NIT) { decode(itn, nxt); tr_load(nxt, v); }
      tr_store(cur, lds);
      __syncthreads();
      cur = nxt; it = itn;
    }
  }
  { const int gt = bid * 512 + tid, gs = G * 512;
    const u32x4 z = {0u, 0u, 0u, 0u};
    u32x4* zp = (u32x4*)(win + (size_t)INW * 1024);
    for (int e = gt; e < (LDP - INW) * 1024 / 8; e += gs) zp[e] = z;
    if (bid == 0) ((u32x4*)(p.ws + OFF_KVC + 2 * SZ_KVC1 * 2))[tid] = z; }
  if (bid >= G - 16) {
    const int w = bid - (G - 16), kv = w >> 3, hd = (w & 7) * 32 + (tid & 31), kq = tid >> 5;
    const float* pos = p.in[kv ? 13 : 10]; const float* w1 = p.in[kv ? 14 : 11];
    float s = 0.f;
    for (int k = kq * 128; k < kq * 128 + 128; ++k) s = __builtin_fmaf(pos[k], w1[(size_t)k * 256 + hd], s);
    LAS float* red = (LAS float*)lds;
    __syncthreads();
    red[tid] = s;
    __syncthreads();
    if (tid < 32) { float a = 0.f;
#pragma unroll
      for (int q = 0; q < 16; ++q) a += red[q * 32 + tid];
      ((float*)(p.ws + OFF_CB))[kv * 256 + hd] = a; }
    __syncthreads();
  }
}
DI void norm_mod_phase(const float* X, bf16_t* U, const float* g, const float* mod, int sh_off, int sc_off, int nwg) {
  const int tid_ = otid(), lane = tid_ & 63, gw = blockIdx.x * 8 + (tid_ >> 6), NW = nwg * 8;
  for (int row = gw; row < MTOK; row += NW) {
    const int b = row >> 11; const f32x4* xr = (const f32x4*)(X + (size_t)row * DM) + lane;
    f32x4 v[4]; float ss = 0.f;
#pragma unroll
    for (int j = 0; j < 4; ++j) { v[j] = xr[64 * j]; ss += (v[j][0] * v[j][0] + v[j][1] * v[j][1]) + (v[j][2] * v[j][2] + v[j][3] * v[j][3]); }
    const float rs = 1.0f / sqrtf(wave_sum(ss) * (1.f / DM) + 1e-6f);
    u32x2* o = (u32x2*)(U + (size_t)row * DM) + lane;
#pragma unroll
    for (int j = 0; j < 4; ++j) { const int col = lane * 4 + 256 * j;
      const f32x4 gg = *(const f32x4*)(g + col), sh = *(const f32x4*)(mod + b * MODW + sh_off + col), sc = *(const f32x4*)(mod + b * MODW + sc_off + col);
      const f32x4 u = (v[j] * rs) * gg * (1.f + sc) + sh;
      u32x2 w; w.x = pk2(u[0], u[1]); w.y = pk2(u[2], u[3]); o[64 * j] = w; }
  }
}
DI void final_norm_phase(float* X, const float* g) {
  const int tid_ = otid(), lane = tid_ & 63, gw = blockIdx.x * 8 + (tid_ >> 6), NW = gridDim.x * 8;
  for (int row = gw; row < MTOK; row += NW) {
    f32x4* xr = (f32x4*)(X + (size_t)row * DM) + lane;
    f32x4 v[4]; float ss = 0.f;
#pragma unroll
    for (int j = 0; j < 4; ++j) { v[j] = xr[64 * j]; ss += (v[j][0] * v[j][0] + v[j][1] * v[j][1]) + (v[j][2] * v[j][2] + v[j][3] * v[j][3]); }
    const float rs = 1.0f / sqrtf(wave_sum(ss) * (1.f / DM) + 1e-6f);
#pragma unroll
    for (int j = 0; j < 4; ++j) { const f32x4 gg = *(const f32x4*)(g + lane * 4 + 256 * j); xr[64 * j] = (v[j] * rs) * gg; }
  }
}
DI void final_scale_phase(const bf16_t* HG, const float* ps, float* out) {
  const int tid_ = otid(), lane = tid_ & 63, gw = blockIdx.x * 8 + (tid_ >> 6), NW = gridDim.x * 8;
  for (int row = gw; row < MTOK; row += NW) {
    const float rs = row_rs(ps, row);
    const u32x4* hr = (const u32x4*)(HG + (size_t)row * DM) + lane; f32x4* o = (f32x4*)(out + (size_t)row * DM) + 2 * lane;
#pragma unroll
    for (int j = 0; j < 2; ++j) { const u32x4 w = hr[64 * j];
      f32x4 a = {bflo(w.x), bfhi(w.x), bflo(w.y), bfhi(w.y)}, b = {bflo(w.z), bfhi(w.z), bflo(w.w), bfhi(w.w)};
      o[128 * j] = a * rs; o[128 * j + 1] = b * rs; }
  }
}
DI void cmp2_phase(const Params& p, LAS unsigned char* lds) {
  const int tid = otid(), lane = tid & 63, wid = tid >> 6;
  const bf16_t* hid = (const bf16_t*)(p.ws + OFF_HID); bf16_t* kc = (bf16_t*)(p.ws + OFF_KC);
  LAS float* w2s = (LAS float*)lds; LAS unsigned char* hids = lds + 65536;
  for (int it = blockIdx.x; it < 256; it += gridDim.x) {
    const int row0 = it * 32, kv = row0 >> 12; const float* w2 = p.in[kv ? 15 : 12];
#pragma unroll
    for (int i = 0; i < 8; ++i) ((LAS f32x4*)w2s)[tid + 512 * i] = ((const f32x4*)w2)[tid + 512 * i];
#pragma unroll
    for (int i = 0; i < 2; ++i) ((LAS u32x4*)hids)[tid + 512 * i] = ((const u32x4*)(hid + (size_t)row0 * 256))[tid + 512 * i];
    __syncthreads();
    float acc[4] = {0.f, 0.f, 0.f, 0.f};
    for (int k8 = 0; k8 < 32; ++k8) {
      u32x4 hv[4];
#pragma unroll
      for (int rr = 0; rr < 4; ++rr) hv[rr] = *(const LAS u32x4*)(hids + ((wid * 4 + rr) * 256 + k8 * 8) * 2);
      float w[8];
#pragma unroll
      for (int e = 0; e < 8; ++e) w[e] = w2s[(k8 * 8 + e) * 64 + lane];
#pragma unroll
      for (int rr = 0; rr < 4; ++rr) {
        acc[rr] = __builtin_fmaf(bflo(hv[rr].x), w[0], acc[rr]); acc[rr] = __builtin_fmaf(bfhi(hv[rr].x), w[1], acc[rr]);
        acc[rr] = __builtin_fmaf(bflo(hv[rr].y), w[2], acc[rr]); acc[rr] = __builtin_fmaf(bfhi(hv[rr].y), w[3], acc[rr]);
        acc[rr] = __builtin_fmaf(bflo(hv[rr].z), w[4], acc[rr]); acc[rr] = __builtin_fmaf(bfhi(hv[rr].z), w[5], acc[rr]);
        acc[rr] = __builtin_fmaf(bflo(hv[rr].w), w[6], acc[rr]); acc[rr] = __builtin_fmaf(bfhi(hv[rr].w), w[7], acc[rr]);
      }
    }
#pragma unroll
    for (int rr = 0; rr < 4; ++rr) { const float s1 = __shfl_down(acc[rr], 1);
      if (!(lane & 1)) *(unsigned*)(kc + (size_t)(row0 + wid * 4 + rr) * 64 + lane) = pk2(acc[rr], s1); }
    __syncthreads();
  }
}

#define XB_TMO      128
#define XB_XCNT(j)  (256  + 64 * (j))
#define XB_XSUB(j)  (1280 + 64 * (j))
#define XB_XGEN(j)  (2304 + 64 * (j))
#define XB_TOP      3328
#define XB_TOPGEN   3392
#define XCD_BAR_WORDS 3456
#define XB_SPIN_CAP (1u << 18)
DI unsigned xb_ld(unsigned* p) { return __hip_atomic_load(p, __ATOMIC_RELAXED, __HIP_MEMORY_SCOPE_AGENT); }
DI unsigned xb_add(unsigned* p, unsigned v) { return __hip_atomic_fetch_add(p, v, __ATOMIC_RELAXED, __HIP_MEMORY_SCOPE_AGENT); }
DI unsigned xb_xcc_id() { return (unsigned)__builtin_amdgcn_s_getreg((3 << 11) | 20) & 0xFu; }
#define XB_SPIN(cond, bar) do { unsigned _sp = 0; while (cond) { __builtin_amdgcn_s_sleep(1); \
    if ((++_sp & 255u) == 0u) { if (xb_ld(&(bar)[XB_TMO])) break; if (_sp > XB_SPIN_CAP) { atomicAdd(&(bar)[XB_TMO], 1u); break; } } } } while (0)
struct XcdBarrier { unsigned* bar; unsigned x; volatile LAS unsigned* st; };
DI XcdBarrier xcd_barrier_post(unsigned* bar, volatile LAS unsigned* st) {
  XcdBarrier b; b.bar = bar; b.x = xb_xcc_id(); b.st = st;
  if (threadIdx.x == 0) (void)xb_add(&bar[XB_XCNT(b.x)], 1u);
  return b;
}
DI void xcd_barrier_complete(unsigned* bar, unsigned x, unsigned& nloc, unsigned& nx) {
  const unsigned G = gridDim.x * gridDim.y * gridDim.z;
  unsigned sum, cnt, mine, sp = 0u;
  for (;;) {
    sum = 0u; cnt = 0u; mine = 0u;
#pragma unroll
    for (unsigned j = 0; j < 16; ++j) { const unsigned c = xb_ld(&bar[XB_XCNT(j)]); sum += c; cnt += (c > 0u) ? 1u : 0u; mine = (j == x) ? c : mine; }
    if (sum == G) break;
    __builtin_amdgcn_s_sleep(1);
    if ((++sp & 255u) == 0u) { if (xb_ld(&bar[XB_TMO])) break; if (sp > XB_SPIN_CAP) { atomicAdd(&bar[XB_TMO], 1u); break; } }
  }
  nloc = mine > 0u ? mine : 1u; nx = cnt > 0u ? cnt : 1u;
}
DI void xcd_barrier(const XcdBarrier& b) {
  asm volatile("s_waitcnt vmcnt(0)" ::: "memory");
  __syncthreads();
  if (threadIdx.x == 0) {
    unsigned* bar = b.bar;
    __builtin_amdgcn_s_waitcnt(0);
    unsigned nloc = b.st[0], nx = b.st[1];
    if (nloc == 0u) { xcd_barrier_complete(bar, b.x, nloc, nx); b.st[0] = nloc; b.st[1] = nx; }
    const unsigned old = xb_add(&bar[XB_XSUB(b.x)], 1u);
    const unsigned gen = old / nloc;
    if (old + 1u == (gen + 1u) * nloc) {
      __builtin_amdgcn_fence(__ATOMIC_RELEASE, "agent");
      asm volatile("s_waitcnt vmcnt(0)" ::: "memory");
      const unsigned og = xb_add(&bar[XB_TOP], 1u);
      const unsigned tg = og / nx;
      if (og + 1u == (tg + 1u) * nx) xb_add(&bar[XB_TOPGEN], 1u);
      else XB_SPIN(xb_ld(&bar[XB_TOPGEN]) == tg, bar);
      __builtin_amdgcn_fence(__ATOMIC_ACQUIRE, "agent");
      xb_add(&bar[XB_XGEN(b.x)], 1u);
      asm volatile("s_waitcnt vmcnt(0)" ::: "memory");
    } else {
      XB_SPIN(xb_ld(&bar[XB_XGEN(b.x)]) == gen, bar);
      __builtin_amdgcn_fence(__ATOMIC_ACQUIRE, "agent");
      asm volatile("s_waitcnt vmcnt(0)" ::: "memory");
    }
  }
  __syncthreads();
}

extern __shared__ __attribute__((aligned(16))) unsigned char dyn_lds[];
constexpr int LDS_BYTES = 8 * HT_B + 16;
constexpr int NPHASE = 15;

__global__ void __launch_bounds__(512) mega(Params p) {
  LAS unsigned char* lds = (LAS unsigned char*)dyn_lds;
  cg::grid_group grid = cg::this_grid();
  const float* mod = (const float*)(p.ws + OFF_MOD);
  bf16_t* U = (bf16_t*)(p.ws + OFF_U); bf16_t* ACT = (bf16_t*)(p.ws + OFF_ACT);
#ifndef DUPMASK
#define DUPMASK 0
#endif
  if (p.ph_lo < 0) grid.sync();
  if (threadIdx.x == 0) { *(volatile LAS unsigned*)(lds + 8 * HT_B) = 0u; *(volatile LAS unsigned*)(lds + 8 * HT_B + 4) = 0u; }
  __syncthreads();
  (void)xcd_barrier_post((unsigned*)(p.ws + OFF_BAR), (volatile LAS unsigned*)(lds + 8 * HT_B));
#define GSYNC() do { unsigned* _bw = (unsigned*)(p.ws + OFF_BAR); asm volatile("" : "+s"(_bw)); XcdBarrier _xb; _xb.bar = _bw; _xb.x = xb_xcc_id(); _xb.st = (volatile LAS unsigned*)(lds + 8 * HT_B); xcd_barrier(_xb); } while (0)
#define PH_BEGIN(n) if (p.ph_lo <= (n) && (n) < p.ph_hi) { for (int rep = 0; rep < 1 + ((DUPMASK >> (n)) & 1); ++rep) { if (rep) GSYNC();
#define PH_END(n) } if ((n) + 1 < p.ph_hi) GSYNC(); }
  PH_BEGIN(0) phase0(p, lds); PH_END(0)
  float* PS = (float*)(p.ws + OFF_PS); float* GT = (float*)(p.ws + OFF_GT); float* SHW2 = (float*)(p.ws + OFF_SHW2); float* SHW3 = (float*)(p.ws + OFF_SHW3);
  bf16_t* HB = (bf16_t*)p.out;
  bf16_t* U3 = (bf16_t*)(p.ws + OFF_YA);
  PH_BEGIN(1)
    const int G1 = gridDim.x, nsh = (G1 > 2 * NSHU) ? NSHU : 0, nwg = G1 - nsh;
    if ((int)blockIdx.x >= nwg) {
      const int tid = otid(), w = blockIdx.x - nwg; const bool second = w >= 17; const int pn = second ? w - 17 : w;
      bf16_t* slot = (bf16_t*)(p.ws + OFF_SH) + (size_t)w * 256 * 1024;
      { const int b = tid >> 5, k0 = (tid & 31) * 32; const float* s = mod + (second ? 6144 : 3072) + b * MODW + k0; bf16_t* d = slot + b * 1024 + k0;
#pragma unroll
        for (int i = 0; i < 4; ++i) { const f32x4 x0 = *(const f32x4*)(s + 8 * i), x1 = *(const f32x4*)(s + 8 * i + 4);
          u32x4 wv; wv.x = pk2(x0[0], x0[1]); wv.y = pk2(x0[2], x0[3]); wv.z = pk2(x1[0], x1[1]); wv.w = pk2(x1[2], x1[3]); *(u32x4*)(d + 8 * i) = wv; } }
      asm volatile("s_waitcnt vmcnt(0)" ::: "memory");
      __syncthreads();
      gemm_stream(OneUnit{slot, (const bf16_t*)(p.ws + (second ? OFF_WGU2 : OFF_WIN)) + (size_t)pn * 256 * 1024, pn * 256}, 1024, 1024, 1024, EpiShW{second ? SHW3 : SHW2, second ? 5632 : LDP}, lds);
    } else {
      { const int tid = otid();
        for (int e = blockIdx.x * 512 + tid; e < 3 * NB * DM; e += nwg * 512) { const int which = e >> 14, b = (e >> 10) & 15, col = e & 1023;
          GT[e] = which == 2 ? p.in[24][col] : p.in[which ? 20 : 8][col] * (1.f + mod[b * MODW + (which ? 7168 : 4096) + col]); } }
      norm_mod_phase(p.in[0], U, p.in[4], mod, 0, 1024, nwg);
    }
  PH_END(1)
  PH_BEGIN(2) gemm_stream(StdUnits{U, 1024, (const bf16_t*)(p.ws + OFF_WGU1), 1024, 128, 22}, 1024, 1024, 1024, EpiGU<false>{ACT, nullptr, nullptr}, lds); PH_END(2)
#ifdef DUP2
  gemm_stream(StdUnits{U, 1024, (const bf16_t*)(p.ws + OFF_WGU1), 1024, 128, 22}, 1024, 1024, 1024, EpiGU<false>{ACT, nullptr, nullptr}, lds); GSYNC();
#endif
  PH_BEGIN(3) gemm_stream(StdUnits{ACT, FF, (const bf16_t*)(p.ws + OFF_WD1), FF, 128, 4}, FF, FF, FF, EpiResN<false, true, 1>{p.in[0], HB, mod + 2048, GT, U, PS}, lds); PH_END(3)
  PH_BEGIN(5) gemm_stream(StdUnits{U, 1024, (const bf16_t*)(p.ws + OFF_WIN), 1024, 128, 17}, 1024, 1024, 1024, EpiProj{ACT, (bf16_t*)(p.ws + OFF_KVC), PS, SHW2}, lds); PH_END(5)
  PH_BEGIN(6)
    gemm_stream(CmpUnits{(const bf16_t*)(p.ws + OFF_KVC), (const bf16_t*)(p.ws + OFF_W1T)}, 1024, 2048, 2048, EpiHid2{(bf16_t*)(p.ws + OFF_HID), (const float*)(p.ws + OFF_CB)}, lds);
    if (gridDim.x > 64) { if (blockIdx.x >= 32) for (int it = blockIdx.x - 32; it < 1024; it += gridDim.x - 32) swa_unit(p, it, lds); }
    else for (int it = blockIdx.x; it < 1024; it += gridDim.x) swa_unit(p, it, lds);
  PH_END(6)
  PH_BEGIN(7) cmp2_phase(p, lds); PH_END(7)
  PH_BEGIN(8)
    if (gridDim.x == 256) {
      const int w = blockIdx.x, q = w & 31, hi = w >> 5;
      for (int k = 0; k < 4; ++k) { const int q2 = (k & 2) ? ((q + 16) & 31) : q, qt = (k & 1) ? 31 - q2 : q2, bg = hi * 4 + k;
        nsa_unit(p, (bg << 5) | qt, lds); }
    } else for (int it = blockIdx.x; it < 1024; it += gridDim.x) nsa_unit(p, it, lds);
  PH_END(8)
  PH_BEGIN(9)
    gemm_stream<true>(StdUnits{(const bf16_t*)(p.ws + OFF_YA), 1024, (const bf16_t*)(p.ws + OFF_WUP), 1024, 128, 8}, 1024, 1024, 1024, EpiUp2{ACT, U}, lds);
  PH_END(9)
  PH_BEGIN(10) gemm_stream(StdUnits{U, 1024, (const bf16_t*)(p.ws + OFF_WOUT), 1024, 128, 4}, 1024, 1024, 1024, EpiResN<true, true, 2>{HB, HB, mod + 5 * 1024, GT + NB * DM, U3, PS}, lds); PH_END(10)
  PH_BEGIN(12) gemm_stream(StdUnits{U3, 1024, (const bf16_t*)(p.ws + OFF_WGU2), 1024, 128, 22}, 1024, 1024, 1024, EpiGU<true>{ACT, PS, SHW3}, lds); PH_END(12)
  PH_BEGIN(13) gemm_stream(StdUnits{ACT, FF, (const bf16_t*)(p.ws + OFF_WD2), FF, 128, 4}, FF, FF, FF, EpiResN<true, false, 1>{HB, nullptr, mod + 8 * 1024, GT + 2 * NB * DM, U, PS}, lds); PH_END(13)
  PH_BEGIN(14) final_scale_phase(U, PS, p.out); PH_END(14)
}

extern "C" void kernel_launch(void* const* d_in, const int* in_sizes, int n_in, void* d_out, int out_size, void* d_ws, size_t ws_size, hipStream_t stream) {
  static int grid = 0;
  if (grid == 0) {
    if (n_in != 25 || out_size != MTOK * DM || ws_size < WS_END) { fprintf(stderr, "kernel_launch: unexpected shapes (n_in %d out %d ws %zu need %zu)\n", n_in, out_size, ws_size, (size_t)WS_END); grid = -1; return; }
    int dev = 0, cus = 0, per_cu = 0;
    hipGetDevice(&dev);
    hipDeviceGetAttribute(&cus, hipDeviceAttributeMultiprocessorCount, dev);
    hipFuncSetAttribute((const void*)mega, hipFuncAttributeMaxDynamicSharedMemorySize, LDS_BYTES);
    hipOccupancyMaxActiveBlocksPerMultiprocessor(&per_cu, (const void*)mega, 512, LDS_BYTES);
    if (per_cu < 1) { fprintf(stderr, "kernel_launch: occupancy query reports %d blocks per CU\n", per_cu); grid = -1; return; }
    grid = cus;
  }
  if (grid < 0) return;
  if (hipMemsetAsync((char*)d_ws + OFF_BAR, 0, XCD_BAR_WORDS * 4, stream) != hipSuccess) { fprintf(stderr, "kernel_launch: memset of the barrier words failed\n"); return; }
  Params p{};
  for (int i = 0; i < 25; ++i) p.in[i] = (const float*)d_in[i];
  p.out = (float*)d_out; p.ws = (unsigned char*)d_ws;
#if NLAUNCH == 1
  p.ph_lo = 0; p.ph_hi = NPHASE;
  void* args[] = {&p};
  hipError_t e = hipLaunchCooperativeKernel((const void*)mega, dim3(grid), dim3(512), args, LDS_BYTES, stream);
  if (e != hipSuccess) fprintf(stderr, "cooperative launch failed: %s (grid %d)\n", hipGetErrorString(e), grid);
#else
  for (int ph = 0; ph < NPHASE; ++ph) {
    p.ph_lo = ph; p.ph_hi = ph + 1;
    void* args[] = {&p};
    hipError_t e = hipLaunchCooperativeKernel((const void*)mega, dim3(grid), dim3(512), args, LDS_BYTES, stream);
    if (e != hipSuccess) { fprintf(stderr, "launch of phase %d failed: %s\n", ph, hipGetErrorString(e)); break; }
  }
#endif
}
```

```cpp
#include <hip/hip_runtime.h>
#include <hip/hip_cooperative_groups.h>
#include <cstdio>
#include <cstdint>
namespace cg = cooperative_groups;

#ifndef NLAUNCH
#define NLAUNCH 1
#endif

#define DI __device__ __forceinline__
#define LAS __attribute__((address_space(3)))
typedef unsigned short bf16_t;
typedef short bf16x8 __attribute__((ext_vector_type(8)));
typedef short s16x4 __attribute__((ext_vector_type(4)));
typedef float f32x2 __attribute__((ext_vector_type(2)));
typedef float f32x4 __attribute__((ext_vector_type(4)));
typedef float f32x16 __attribute__((ext_vector_type(16)));
typedef unsigned u32x2 __attribute__((ext_vector_type(2)));
typedef unsigned u32x4 __attribute__((ext_vector_type(4)));
typedef __bf16 bf16v2 __attribute__((ext_vector_type(2)));

constexpr int NB = 16, SEQ = 2048, DM = 1024, MTOK = NB * SEQ, FF = 2816, LDP = 4352, INW = 4120, MODW = 9216;
constexpr float LOG2E = 1.4426950408889634f;
constexpr float C1 = 0.125f * LOG2E;

constexpr size_t SZ_WGU = (size_t)5632 * 1024 * 2, SZ_WD = (size_t)1024 * 2816 * 2;
constexpr size_t OFF_WGU1 = 0;
constexpr size_t OFF_WD1 = OFF_WGU1 + SZ_WGU;
constexpr size_t OFF_WGU2 = OFF_WD1 + SZ_WD;
constexpr size_t OFF_WD2 = OFF_WGU2 + SZ_WGU;
constexpr size_t OFF_WIN = OFF_WD2 + SZ_WD;
constexpr size_t OFF_WUPA = OFF_WIN + (size_t)LDP * 1024 * 2;
constexpr size_t OFF_WUPB = OFF_WUPA + (size_t)1024 * 512 * 2;
constexpr size_t OFF_WOUT = OFF_WUPB + (size_t)1024 * 512 * 2;
constexpr size_t OFF_W1T = OFF_WOUT + (size_t)1024 * 1024 * 2;
constexpr size_t OFF_MOD = OFF_W1T + (size_t)2 * 256 * 2048 * 2;
constexpr size_t OFF_CB = OFF_MOD + (size_t)NB * MODW * 4;
constexpr size_t OFF_U = OFF_CB + 4096;
constexpr size_t OFF_ACT = OFF_U + (size_t)MTOK * 1024 * 2;
constexpr size_t OFF_YA = OFF_ACT + (size_t)MTOK * LDP * 2;
constexpr size_t OFF_YB = OFF_YA + (size_t)MTOK * 512 * 2;
constexpr size_t OFF_KVC = OFF_YB + (size_t)MTOK * 512 * 2;
constexpr size_t SZ_KVC1 = (size_t)NB * 2 * SEQ * 64;
constexpr size_t OFF_HID = OFF_KVC + 2 * SZ_KVC1 * 2 + 8192;
constexpr size_t OFF_KC = OFF_HID + (size_t)2 * 4096 * 256 * 2;
constexpr size_t OFF_GT = OFF_KC + (size_t)2 * 4096 * 64 * 2;
constexpr size_t OFF_SHW2 = OFF_GT + (size_t)3 * NB * DM * 4;
constexpr size_t OFF_SHW3 = OFF_SHW2 + (size_t)NB * LDP * 4;
constexpr size_t OFF_PS = OFF_SHW3 + (size_t)NB * 5632 * 4;
constexpr size_t OFF_SH = OFF_PS + (size_t)MTOK * 16 * 4;
constexpr int NSHU = 17 + 22;
constexpr size_t OFF_BAR = OFF_SH + (size_t)NSHU * 256 * 1024 * 2;
constexpr size_t WS_END = OFF_BAR + 16384;

struct Params {
  const float* in[25];
  float* out;
  unsigned char* ws;
  int ph_lo, ph_hi;
};

DI unsigned pk2(float lo, float hi) { bf16v2 v = __builtin_convertvector((f32x2){lo, hi}, bf16v2); return __builtin_bit_cast(unsigned, v); }
DI float bf2f(unsigned short v) { return __uint_as_float((unsigned)v << 16); }
DI float bflo(unsigned v) { return __uint_as_float(v << 16); }
DI float bfhi(unsigned v) { return __uint_as_float(v & 0xffff0000u); }
DI float fexp2(float x) { return __builtin_amdgcn_exp2f(x); }
DI float frcp(float x) { return __builtin_amdgcn_rcpf(x); }
DI float sigm(float x) { return frcp(1.f + fexp2(-LOG2E * x)); }
DI float silu_(float x) { return x * sigm(x); }
DI float gelu_tanh(float x) { const float z = 0.7978845608f * (x + 0.044715f * x * x * x); return x * sigm(2.f * z); }
DI int otid() { int t = threadIdx.x; asm volatile("" : "+v"(t)); return t; }
DI float wave_sum(float v) {
#pragma unroll
  for (int o = 1; o < 64; o <<= 1) v += __shfl_xor(v, o);
  return v;
}

constexpr int HT_B = 128 * 64 * 2;
DI int lds_byte(int r, int c) { const int st = (r >> 4) * 2 + (c >> 5), rr = r & 15, cc = c & 31, ob = rr * 64 + cc * 2; return st * 1024 + (ob ^ (((ob >> 9) & 1) << 5)); }
DI void stage_rc(int b, int& R, int& C) { const int st = b / 1024, sb = b % 1024, swz = sb ^ (((sb >> 9) & 1) << 5); R = (st >> 1) * 16 + swz / 64; C = (st & 1) * 32 + (swz % 64) / 2; }
DI int perm32(int rho) { const int n = rho >> 4, i = rho & 15; return 8 * (i >> 2) + 4 * n + (i & 3); }

struct UnitD { const bf16_t* a; const bf16_t* b; int brow, bcol, aux; };
DI bool unit_of(int L, int nM, int nN, int& pm, int& pn) {
  const int nwg = nM * nN; if (L >= nwg) return false;
  int wgid = L; { const int q = nwg / 8, r = nwg % 8, xcd = wgid % 8, off = wgid / 8; wgid = (xcd < r ? xcd * (q + 1) : r * (q + 1) + (xcd - r) * q) + off; }
  const int nig = 8 * nN, gid = wgid / nig, fm = gid * 8, gsz = (nM - fm) < 8 ? (nM - fm) : 8;
  pm = fm + ((wgid % nig) % gsz); pn = (wgid % nig) / gsz; return true;
}
struct StdUnits { const bf16_t* A; int lda; const bf16_t* Bt; int ldb; int nM, nN;
  DI bool next(int i, UnitD& d) const { int pm, pn; if (!unit_of(i * (int)gridDim.x + (int)blockIdx.x, nM, nN, pm, pn)) return false;
    d.brow = pm * 256; d.bcol = pn * 256; d.aux = 0; d.a = A + (size_t)d.brow * lda; d.b = Bt + (size_t)d.bcol * ldb; return true; } };

#define EPI_ARGS const f32x4 (&acc)[2][2][4][2], int brow, int bcol, int aux, int wr, int wc, int fr, int fq
template <class Units, class Epi>
DI void gemm_stream(const Units& S, const int lda, const int ldb, const int K, const Epi& epi, LAS unsigned char* lds) {
  const int tid = threadIdx.x, wid = __builtin_amdgcn_readfirstlane(tid >> 6), lane = tid & 63, wr = wid >> 2, wc = wid & 3, fr = lane & 15, fq = lane >> 4;
  const int nt = K / 64;
  int R, C; stage_rc(tid * 16, R, C);
  const size_t offA = (size_t)R * lda + C, offB = (size_t)((R & ~31) + perm32(R & 31)) * ldb + C;
  const size_t a64 = (size_t)64 * lda, b64 = (size_t)64 * ldb, ah = (size_t)128 * lda, bh = (size_t)128 * ldb;
  const unsigned ldsw = (unsigned)wid * 1024u;
  const int aoff = lds_byte(wr * 64 + fr, fq * 8), boff = lds_byte(wc * 32 + fr, fq * 8);
#define G_SA(b, h) (((b) * 2 + (h)) * HT_B)
#define G_SB(b, h) ((4 + (b) * 2 + (h)) * HT_B)
#define G_STAGE(bufoff, gp, st64) do { const bf16_t* _g = (gp); \
    __builtin_amdgcn_global_load_lds((const unsigned*)_g, (LAS unsigned*)(lds + (bufoff) + ldsw), 16, 0, 0); \
    __builtin_amdgcn_global_load_lds((const unsigned*)(_g + (st64)), (LAS unsigned*)(lds + (bufoff) + ldsw + 8192), 16, 0, 0); } while (0)
#define G_LDA(dst, b, h) do { _Pragma("unroll") for (int m = 0; m < 4; ++m) _Pragma("unroll") for (int k = 0; k < 2; ++k) dst[m][k] = *(const LAS bf16x8*)(lds + G_SA(b, h) + aoff + m * 2048 + k * 1024); } while (0)
#define G_LDB(dst, b, h) do { _Pragma("unroll") for (int n = 0; n < 2; ++n) _Pragma("unroll") for (int k = 0; k < 2; ++k) dst[n][k] = *(const LAS bf16x8*)(lds + G_SB(b, h) + boff + n * 2048 + k * 1024); } while (0)
#define G_MMA(ai, bj, At, Bq) do { __builtin_amdgcn_s_setprio(1); _Pragma("unroll") for (int m = 0; m < 4; ++m) _Pragma("unroll") for (int n = 0; n < 2; ++n) _Pragma("unroll") for (int k = 0; k < 2; ++k) \
    acc[ai][bj][m][n] = __builtin_amdgcn_mfma_f32_16x16x32_bf16(Bq[n][k], At[m][k], acc[ai][bj][m][n], 0, 0, 0); __builtin_amdgcn_s_setprio(0); } while (0)
#define WAIT_V(n) asm volatile("s_waitcnt vmcnt(" #n ")" ::: "memory")
#define WAIT_L(n) asm volatile("s_waitcnt lgkmcnt(" #n ")" ::: "memory")
#define BAR __builtin_amdgcn_s_barrier()
#define SCHED __builtin_amdgcn_sched_barrier(0)
  UnitD cur, nxt; int ui = 0;
  if (!S.next(0, cur)) return;
  f32x4 acc[2][2][4][2];
#pragma unroll
  for (int a = 0; a < 2; ++a)
#pragma unroll
    for (int b = 0; b < 2; ++b)
#pragma unroll
      for (int m = 0; m < 4; ++m)
#pragma unroll
        for (int n = 0; n < 2; ++n) acc[a][b][m][n] = (f32x4){0.f, 0.f, 0.f, 0.f};
  bf16x8 At[4][2], B0[2][2], B1[2][2];
  const bf16_t* cA = cur.a + offA; const bf16_t* cB = cur.b + offB;
  G_STAGE(G_SB(0, 0), cB, b64); G_STAGE(G_SB(0, 1), cB + bh, b64); G_STAGE(G_SA(0, 0), cA, a64); G_STAGE(G_SA(0, 1), cA + ah, a64);
  if (wr == 1) BAR;
  WAIT_V(2); BAR;
  G_STAGE(G_SB(1, 0), cB + 64, b64); G_STAGE(G_SA(1, 0), cA + 64, a64); G_STAGE(G_SB(1, 1), cB + bh + 64, b64);
  WAIT_V(6); BAR;
  for (;;) {
    const bool has_next = S.next(ui + 1, nxt);
    const bf16_t* nA = has_next ? nxt.a + offA : cA; const bf16_t* nB = has_next ? nxt.b + offB : cB;
    for (int t = 0; t < nt; t += 2) {
      const bool last = (t == nt - 2);
      const bf16_t* a1 = cA + (size_t)(t + 1) * 64;
      const bf16_t* a2 = last ? nA : cA + (size_t)(t + 2) * 64; const bf16_t* b2 = last ? nB : cB + (size_t)(t + 2) * 64;
      const bf16_t* a3 = a2 + 64; const bf16_t* b3 = b2 + 64;
      G_LDB(B0, 0, 0); G_LDB(B1, 0, 1); SCHED; G_LDA(At, 0, 0); G_STAGE(G_SA(1, 1), a1 + ah, a64);
      WAIT_V(8); WAIT_L(0); BAR; G_MMA(0, 0, At, B0); G_MMA(0, 1, At, B1); BAR; SCHED;
      G_LDA(At, 0, 1); G_STAGE(G_SB(0, 0), b2, b64); G_STAGE(G_SB(0, 1), b2 + bh, b64); G_STAGE(G_SA(0, 0), a2, a64);
      WAIT_V(8); WAIT_L(0); BAR; G_MMA(1, 0, At, B0); G_MMA(1, 1, At, B1); BAR; SCHED;
      G_LDB(B0, 1, 0); G_LDB(B1, 1, 1); SCHED; G_LDA(At, 1, 0); G_STAGE(G_SA(0, 1), a2 + ah, a64);
      WAIT_V(8); WAIT_L(0); BAR; G_MMA(0, 0, At, B0); G_MMA(0, 1, At, B1); BAR; SCHED;
      G_LDA(At, 1, 1); G_STAGE(G_SB(1, 0), b3, b64); G_STAGE(G_SB(1, 1), b3 + bh, b64); G_STAGE(G_SA(1, 0), a3, a64);
      WAIT_V(8); WAIT_L(0); BAR; G_MMA(1, 0, At, B0); G_MMA(1, 1, At, B1); BAR; SCHED;
    }
    if (wr == 0) BAR;
    epi(acc, cur.brow, cur.bcol, cur.aux, wr, wc, fr, fq);
    if (!has_next) break;
#pragma unroll
    for (int a = 0; a < 2; ++a)
#pragma unroll
      for (int b = 0; b < 2; ++b)
#pragma unroll
        for (int m = 0; m < 4; ++m)
#pragma unroll
          for (int n = 0; n < 2; ++n) acc[a][b][m][n] = (f32x4){0.f, 0.f, 0.f, 0.f};
    cur = nxt; cA = nA; cB = nB; ++ui;
    if (wr == 1) BAR;
  }
  WAIT_V(0);
  BAR;
}

#define EPI_ROWS _Pragma("unroll") for (int ai = 0; ai < 2; ++ai) _Pragma("unroll") for (int m = 0; m < 4; ++m)
DI float row_rs(const float* ps, int row) {
  const f32x4* q = (const f32x4*)(ps + (size_t)row * 16); const f32x4 a = q[0], b = q[1], c = q[2], d = q[3];
  const float s = ((a[0] + a[1]) + (a[2] + a[3])) + ((b[0] + b[1]) + (b[2] + b[3])) + ((c[0] + c[1]) + (c[2] + c[3])) + ((d[0] + d[1]) + (d[2] + d[3]));
  return 1.0f / sqrtf(s * (1.f / DM) + 1e-6f);
}
template <bool NORM> struct EpiGU {
  bf16_t* act; const float* ps; const float* shw;
  DI void operator()(EPI_ARGS) const {
    const int oc0 = (bcol >> 1) + wc * 32 + fq * 8;
    f32x4 sg0, sg1, su0, su1;
    if (NORM) { const float* sp = shw + (size_t)(brow >> 11) * 5632 + bcol + wc * 32 + fq * 8; sg0 = *(const f32x4*)sp; sg1 = *(const f32x4*)(sp + 4); su0 = *(const f32x4*)(sp + 128); su1 = *(const f32x4*)(sp + 132); }
    EPI_ROWS { const int row = brow + ai * 128 + wr * 64 + m * 16 + fr;
      f32x4 g0 = acc[ai][0][m][0], g1 = acc[ai][0][m][1], u0 = acc[ai][1][m][0], u1 = acc[ai][1][m][1];
      if (NORM) { const float rs = row_rs(ps, row); g0 = g0 * rs + sg0; g1 = g1 * rs + sg1; u0 = u0 * rs + su0; u1 = u1 * rs + su1; }
      u32x4 w; w.x = pk2(silu_(g0[0]) * u0[0], silu_(g0[1]) * u0[1]); w.y = pk2(silu_(g0[2]) * u0[2], silu_(g0[3]) * u0[3]);
      w.z = pk2(silu_(g1[0]) * u1[0], silu_(g1[1]) * u1[1]); w.w = pk2(silu_(g1[2]) * u1[2], silu_(g1[3]) * u1[3]);
      *(u32x4*)(act + (size_t)row * FF + oc0) = w; }
  }
};
struct EpiRes {
  const float* Hin; float* Hout; const float* gate; float coef;
  DI void operator()(EPI_ARGS) const {
    EPI_ROWS { const int row = brow + ai * 128 + wr * 64 + m * 16 + fr; const int b = row >> 11;
#pragma unroll
      for (int bj = 0; bj < 2; ++bj)
#pragma unroll
        for (int n = 0; n < 2; ++n) { const int col = bcol + bj * 128 + wc * 32 + fq * 8 + n * 4;
          const f32x4 hin = *(const f32x4*)(Hin + (size_t)row * DM + col); const f32x4 g4 = *(const f32x4*)(gate + b * MODW + col);
          *(f32x4*)(Hout + (size_t)row * DM + col) = hin + coef * g4 * acc[ai][bj][m][n]; } }
  }
};
template <bool HIN_BF16, bool WRITE_H, int COEF2> struct EpiResN {
  const void* Hin; bf16_t* Hout; const float* gate; const float* gtab; bf16_t* Un; float* ps;
  DI void operator()(EPI_ARGS) const {
    constexpr float coef = 0.5f * COEF2;
    const int b = brow >> 11;
    f32x4 ssA = {0.f, 0.f, 0.f, 0.f}, ssB = {0.f, 0.f, 0.f, 0.f};
#pragma unroll
    for (int bj = 0; bj < 2; ++bj) { const int col = bcol + bj * 128 + wc * 32 + fq * 8;
      const f32x4 g0 = coef * *(const f32x4*)(gate + b * MODW + col), g1 = coef * *(const f32x4*)(gate + b * MODW + col + 4);
      const f32x4 t0 = *(const f32x4*)(gtab + b * DM + col), t1 = *(const f32x4*)(gtab + b * DM + col + 4);
      EPI_ROWS { const size_t off = (size_t)(brow + ai * 128 + wr * 64 + m * 16 + fr) * DM + col;
        f32x4 x0, x1;
        if (HIN_BF16) { const u32x4 hw = *(const u32x4*)((const bf16_t*)Hin + off);
          x0[0] = bflo(hw.x); x0[1] = bfhi(hw.x); x0[2] = bflo(hw.y); x0[3] = bfhi(hw.y); x1[0] = bflo(hw.z); x1[1] = bfhi(hw.z); x1[2] = bflo(hw.w); x1[3] = bfhi(hw.w); }
        else { x0 = *(const f32x4*)((const float*)Hin + off); x1 = *(const f32x4*)((const float*)Hin + off + 4); }
        const f32x4 h0 = x0 + g0 * acc[ai][bj][m][0], h1 = x1 + g1 * acc[ai][bj][m][1];
        if (WRITE_H) { u32x4 hv; hv.x = pk2(h0[0], h0[1]); hv.y = pk2(h0[2], h0[3]); hv.z = pk2(h1[0], h1[1]); hv.w = pk2(h1[2], h1[3]); *(u32x4*)(Hout + off) = hv; }
        const f32x4 a0 = h0 * t0, a1 = h1 * t1;
        u32x4 w; w.x = pk2(a0[0], a0[1]); w.y = pk2(a0[2], a0[3]); w.z = pk2(a1[0], a1[1]); w.w = pk2(a1[2], a1[3]);
        *(u32x4*)(Un + off) = w;
        const float sq = ((h0[0] * h0[0] + h0[1] * h0[1]) + (h0[2] * h0[2] + h0[3] * h0[3])) + ((h1[0] * h1[0] + h1[1] * h1[1]) + (h1[2] * h1[2] + h1[3] * h1[3]));
        if (ai == 0) ssA[m] += sq; else ssB[m] += sq; } }
    EPI_ROWS { float s = ai == 0 ? ssA[m] : ssB[m]; s += __shfl_xor(s, 16); s += __shfl_xor(s, 32);
      if (fq == 0) ps[(size_t)(brow + ai * 128 + wr * 64 + m * 16 + fr) * 16 + (bcol >> 8) * 4 + wc] = s; }
  }
};
struct EpiShW {
  float* out; int ldo;
  DI void operator()(EPI_ARGS) const {
    if (wr == 0) {
#pragma unroll
      for (int bj = 0; bj < 2; ++bj) { float* o = out + (size_t)fr * ldo + bcol + bj * 128 + wc * 32 + fq * 8;
        *(f32x4*)o = acc[0][bj][0][0]; *(f32x4*)(o + 4) = acc[0][bj][0][1]; }
    }
  }
};
struct OneUnit { const bf16_t* a; const bf16_t* b; int bcol;
  DI bool next(int i, UnitD& d) const { if (i > 0) return false; d.brow = 0; d.bcol = bcol; d.aux = 0; d.a = a; d.b = b; return true; } };
struct EpiProj {
  bf16_t* proj; bf16_t* kvc; const float* ps; const float* shw;
  DI void operator()(EPI_ARGS) const {
    f32x4 sw[2][2];
    { const float* sp = shw + (size_t)(brow >> 11) * LDP + bcol + wc * 32 + fq * 8; sw[0][0] = *(const f32x4*)sp; sw[0][1] = *(const f32x4*)(sp + 4); sw[1][0] = *(const f32x4*)(sp + 128); sw[1][1] = *(const f32x4*)(sp + 132); }
    EPI_ROWS { const int row = brow + ai * 128 + wr * 64 + m * 16 + fr; const float rs = row_rs(ps, row);
#pragma unroll
      for (int bj = 0; bj < 2; ++bj) { const int col = bcol + bj * 128 + wc * 32 + fq * 8; const f32x4 v0 = acc[ai][bj][m][0] * rs + sw[bj][0], v1 = acc[ai][bj][m][1] * rs + sw[bj][1];
        u32x4 w; w.x = pk2(v0[0], v0[1]); w.y = pk2(v0[2], v0[3]); w.z = pk2(v1[0], v1[1]); w.w = pk2(v1[2], v1[3]);
        *(u32x4*)(proj + (size_t)row * LDP + col) = w;
        if (bcol == 512) { const int c = col - 512, kv = c >> 7, g = (c >> 6) & 1, d = c & 63, b = row >> 11, s = row & 2047;
          *(u32x4*)(kvc + ((((size_t)kv * NB + b) * 2 + g) * SEQ + s) * 64 + d) = w; } } }
  }
};
struct EpiHid {
  bf16_t* hid; const float* bias;
  DI void operator()(EPI_ARGS) const {
    EPI_ROWS { const int row = brow + ai * 128 + wr * 64 + m * 16 + fr;
#pragma unroll
      for (int bj = 0; bj < 2; ++bj) { const int col = bcol + bj * 128 + wc * 32 + fq * 8;
        const f32x4 v0 = acc[ai][bj][m][0] + *(const f32x4*)(bias + col), v1 = acc[ai][bj][m][1] + *(const f32x4*)(bias + col + 4);
        u32x4 w; w.x = pk2(gelu_tanh(v0[0]), gelu_tanh(v0[1])); w.y = pk2(gelu_tanh(v0[2]), gelu_tanh(v0[3])); w.z = pk2(gelu_tanh(v1[0]), gelu_tanh(v1[1])); w.w = pk2(gelu_tanh(v1[2]), gelu_tanh(v1[3]));
        *(u32x4*)(hid + (size_t)row * 256 + col) = w; } }
  }
};
struct EpiUp {
  bf16_t* proj; bf16_t* merged;
  DI void operator()(EPI_ARGS) const {
    EPI_ROWS { const int row = brow + ai * 128 + wr * 64 + m * 16 + fr; bf16_t* pr = proj + (size_t)row * LDP;
#pragma unroll
      for (int bj = 0; bj < 2; ++bj) { const int col = bcol + bj * 128 + wc * 32 + fq * 8; const f32x4 v0 = acc[ai][bj][m][0], v1 = acc[ai][bj][m][1];
        const u32x4 gw = *(const u32x4*)(pr + 2048 + aux * 1024 + col);
        f32x4 o0, o1; o0[0] = sigm(bflo(gw.x)) * v0[0]; o0[1] = sigm(bfhi(gw.x)) * v0[1]; o0[2] = sigm(bflo(gw.y)) * v0[2]; o0[3] = sigm(bfhi(gw.y)) * v0[3];
        o1[0] = sigm(bflo(gw.z)) * v1[0]; o1[1] = sigm(bfhi(gw.z)) * v1[1]; o1[2] = sigm(bflo(gw.w)) * v1[2]; o1[3] = sigm(bfhi(gw.w)) * v1[3];
        bf16_t* tp = pr + col;
        if (aux == 0) { u32x4 w; w.x = pk2(o0[0], o0[1]); w.y = pk2(o0[2], o0[3]); w.z = pk2(o1[0], o1[1]); w.w = pk2(o1[2], o1[3]); *(u32x4*)tp = w; }
        else { const u32x4 tw = *(const u32x4*)tp;
          f32x4 t0, t1; t0[0] = bflo(tw.x) + o0[0]; t0[1] = bfhi(tw.x) + o0[1]; t0[2] = bflo(tw.y) + o0[2]; t0[3] = bfhi(tw.y) + o0[3];
          t1[0] = bflo(tw.z) + o1[0]; t1[1] = bfhi(tw.z) + o1[1]; t1[2] = bflo(tw.w) + o1[2]; t1[3] = bfhi(tw.w) + o1[3];
          u32x4 w; w.x = pk2(t0[0], t0[1]); w.y = pk2(t0[2], t0[3]); w.z = pk2(t1[0], t1[1]); w.w = pk2(t1[2], t1[3]);
          *(u32x4*)(merged + (size_t)row * DM + col) = w; } } }
  }
};
struct UpUnits { const bf16_t* ya; const bf16_t* yb; const bf16_t* wa; const bf16_t* wb;
  DI bool next(int i, UnitD& d) const { int pm, pn; if (!unit_of((i >> 1) * (int)gridDim.x + (int)blockIdx.x, 128, 4, pm, pn)) return false;
    d.brow = pm * 256; d.bcol = pn * 256; d.aux = i & 1; d.a = ((i & 1) ? yb : ya) + (size_t)d.brow * 512; d.b = ((i & 1) ? wb : wa) + (size_t)d.bcol * 512; return true; } };
struct CmpUnits { const bf16_t* kvc; const bf16_t* w1t;
  DI bool next(int i, UnitD& d) const { if (i > 0 || blockIdx.x >= 32) return false; const int kv = blockIdx.x >> 4, pm = blockIdx.x & 15;
    d.brow = pm * 256; d.bcol = 0; d.aux = kv; d.a = kvc + (size_t)kv * SZ_KVC1 + (size_t)d.brow * 1024; d.b = w1t + (size_t)kv * 256 * 2048; return true; } };
struct EpiHid2 { bf16_t* hid; const float* cb;
  DI void operator()(EPI_ARGS) const { EpiHid{hid + (size_t)aux * 4096 * 256, cb + aux * 256}(acc, brow, bcol, aux, wr, wc, fr, fq); } };

constexpr int VST = 192;
constexpr int AL_SLOT = 9216 + 64 * VST;
constexpr int AL_IA = 2 * AL_SLOT, AL_IB = AL_IA + 4 * 64 * 33 * 4, AL_SEL = AL_IB + 4 * 64 * 33 * 4, AL_UNI = AL_SEL + 256;
#define MFMA32(a, b, c) __builtin_amdgcn_mfma_f32_32x32x16_bf16((a), (b), (c), 0, 0, 0)

struct TileP { int j; int lim_hi, lim_lo; float rowbias; };

DI void tile_scores(const int slot, const bf16x8 (&qf)[4], f32x16& s0, f32x16& s1, LAS unsigned char* lds) {
  const int lane = otid() & 63, r = lane & 31, h = lane >> 5;
#pragma unroll
  for (int i = 0; i < 16; ++i) { s0[i] = 0.f; s1[i] = 0.f; }
  LAS unsigned char* kl = lds + slot * AL_SLOT + r * 144 + h * 16;
#pragma unroll
  for (int ks = 0; ks < 4; ++ks) {
    const bf16x8 k0 = *(const LAS bf16x8*)(kl + ks * 32);
    const bf16x8 k1 = *(const LAS bf16x8*)(kl + 32 * 144 + ks * 32);
    s0 = MFMA32(k0, qf[ks], s0);
    s1 = MFMA32(k1, qf[ks], s1);
  }
}
template <int MODE, bool MASKED>
DI void tile_softmax(const TileP& tp, f32x16& s0, f32x16& s1, const float slope2, const int t, f32x16 (&o)[2], float& m, float& l, float (&G)[8], float (&Lr)[8]) {
  const int lane = threadIdx.x & 63, h = lane >> 5;
  float base, cstep;
  if (MODE == 0) { base = slope2 * (float)(16 * (tp.j * 64 + 4 * h) + 31 - t); cstep = 16.f * slope2; }
  else { base = slope2 * (float)(tp.j * 64 + 4 * h - t) + tp.rowbias; cstep = slope2; }
  float tm = -1e30f;
#pragma unroll
  for (int i = 0; i < 16; ++i) {
    const int c0 = 8 * (i >> 2) + (i & 3), c1 = 32 + c0;
    float v0 = __builtin_fmaf(s0[i], C1, __builtin_fmaf(cstep, (float)c0, base));
    float v1 = __builtin_fmaf(s1[i], C1, __builtin_fmaf(cstep, (float)c1, base));
    if (MASKED) { v0 = (c0 <= tp.lim_hi && c0 >= tp.lim_lo) ? v0 : -1e30f; v1 = (c1 <= tp.lim_hi && c1 >= tp.lim_lo) ? v1 : -1e30f; }
    s0[i] = v0; s1[i] = v1; tm = fmaxf(tm, fmaxf(v0, v1));
  }
  tm = fmaxf(tm, __shfl_xor(tm, 32));
  const float mn = fmaxf(m, tm), alpha = fexp2(m - mn); m = mn;
  float ls = 0.f;
#pragma unroll
  for (int i = 0; i < 16; ++i) { const float p0 = fexp2(s0[i] - mn), p1 = fexp2(s1[i] - mn); s0[i] = p0; s1[i] = p1; ls += p0 + p1; }
  l = l * alpha + ls;
#pragma unroll
  for (int i = 0; i < 16; ++i) { o[0][i] *= alpha; o[1][i] *= alpha; }
  if (MODE == 0) {
#pragma unroll
    for (int g4 = 0; g4 < 4; ++g4) {
      G[g4] = (s0[4 * g4] + s0[4 * g4 + 1]) + (s0[4 * g4 + 2] + s0[4 * g4 + 3]); Lr[g4] = s0[4 * g4 + 3];
      G[4 + g4] = (s1[4 * g4] + s1[4 * g4 + 1]) + (s1[4 * g4 + 2] + s1[4 * g4 + 3]); Lr[4 + g4] = s1[4 * g4 + 3];
    }
  }
}
DI void tile_pv(const int slot, const f32x16& s0, const f32x16& s1, f32x16 (&o)[2], LAS unsigned char* lds) {
  const int lane = otid() & 63, h = lane >> 5;
  const int i16 = lane & 15, q4 = i16 >> 2, p4 = i16 & 3, blk = (lane >> 4) & 1;
  LAS unsigned char* vl = lds + slot * AL_SLOT + 9216 + (4 * h + q4) * VST + blk * 32 + 8 * p4;
#pragma unroll
  for (int kb = 0; kb < 2; ++kb)
#pragma unroll
    for (int sp = 0; sp < 2; ++sp) {
      u32x4 pw;
      if (kb == 0) { pw.x = pk2(s0[8 * sp], s0[8 * sp + 1]); pw.y = pk2(s0[8 * sp + 2], s0[8 * sp + 3]); pw.z = pk2(s0[8 * sp + 4], s0[8 * sp + 5]); pw.w = pk2(s0[8 * sp + 6], s0[8 * sp + 7]); }
      else { pw.x = pk2(s1[8 * sp], s1[8 * sp + 1]); pw.y = pk2(s1[8 * sp + 2], s1[8 * sp + 3]); pw.z = pk2(s1[8 * sp + 4], s1[8 * sp + 5]); pw.w = pk2(s1[8 * sp + 6], s1[8 * sp + 7]); }
      const bf16x8 pf = __builtin_bit_cast(bf16x8, pw);
      LAS unsigned char* vb = vl + (kb * 32 + 16 * sp) * VST;
#pragma unroll
      for (int db = 0; db < 2; ++db) {
        const s16x4 lo = __builtin_amdgcn_ds_read_tr16_b64_v4i16((LAS s16x4*)(vb + db * 64));
        const s16x4 hi = __builtin_amdgcn_ds_read_tr16_b64_v4i16((LAS s16x4*)(vb + db * 64 + 8 * VST));
        const bf16x8 vf = __builtin_shufflevector(lo, hi, 0, 1, 2, 3, 4, 5, 6, 7);
        o[db] = MFMA32(vf, pf, o[db]);
      }
    }
}
template <int MODE, bool MA, bool MB>
DI void pair_compute(const TileP& ta, const TileP& tb, const bf16x8 (&qf)[4], const float slope2, const int t, f32x16 (&o)[2], float& m, float& l,
                     float (&GA)[8], float (&LA)[8], float (&GB)[8], float (&LB)[8], float& m_after_a, LAS unsigned char* lds) {
  const bool early = (MODE != 0) && ((threadIdx.x >> 8) & 1) != 0;
  f32x16 a0, a1, b0, b1;
  tile_scores(0, qf, a0, a1, lds);
  if (early) tile_scores(1, qf, b0, b1, lds);
  __builtin_amdgcn_sched_barrier(0);
  tile_softmax<MODE, MA>(ta, a0, a1, slope2, t, o, m, l, GA, LA);
  m_after_a = m;
  __builtin_amdgcn_sched_barrier(0);
  tile_pv(0, a0, a1, o, lds);
  __builtin_amdgcn_sched_barrier(0);
  if (!early) tile_scores(1, qf, b0, b1, lds);
  __builtin_amdgcn_sched_barrier(0);
  tile_softmax<MODE, MB>(tb, b0, b1, slope2, t, o, m, l, GB, LB);
  __builtin_amdgcn_sched_barrier(0);
  tile_pv(1, b0, b1, o, lds);
}
template <int MODE, bool MA>
DI void single_compute(const TileP& ta, const bf16x8 (&qf)[4], const float slope2, const int t, f32x16 (&o)[2], float& m, float& l, LAS unsigned char* lds) {
  f32x16 a0, a1; float Gd[8], Ld[8];
  tile_scores(0, qf, a0, a1, lds);
  tile_softmax<MODE, MA>(ta, a0, a1, slope2, t, o, m, l, Gd, Ld);
  tile_pv(0, a0, a1, o, lds);
}
struct StageRegs { u32x4 k0, v0, k1, v1; };
DI void stage_load(StageRegs& sr, const bf16_t* Kp, const bf16_t* Vp, const int stride, const int ja, const int jb) {
  const int tid = otid(), srow = tid >> 3, sch = tid & 7;
  sr.k0 = *(const u32x4*)(Kp + (size_t)(ja * 64 + srow) * stride + sch * 8);
  sr.v0 = *(const u32x4*)(Vp + (size_t)(ja * 64 + srow) * stride + sch * 8);
  sr.k1 = *(const u32x4*)(Kp + (size_t)(jb * 64 + srow) * stride + sch * 8);
  sr.v1 = *(const u32x4*)(Vp + (size_t)(jb * 64 + srow) * stride + sch * 8);
}
DI void stage_store(const StageRegs& sr, LAS unsigned char* lds) {
  const int tid = otid(), srow = tid >> 3, sch = tid & 7;
  LAS unsigned char* d = lds + srow * 144 + sch * 16; LAS unsigned char* dv = lds + 9216 + srow * VST + sch * 16;
  *(LAS u32x4*)(d) = sr.k0; *(LAS u32x4*)(dv) = sr.v0; *(LAS u32x4*)(d + AL_SLOT) = sr.k1; *(LAS u32x4*)(dv + AL_SLOT) = sr.v1;
}

template <int MODE>
DI void attn_branch(unsigned tilemask, const bf16_t* Kp, const bf16_t* Vp, const int stride, const bf16x8 (&qf)[4], const float slope2, const int t, const int cur,
                    const unsigned mysel, f32x16 (&o)[2], float& m, float& l, LAS unsigned char* lds) {
  const int lane = threadIdx.x & 63, h = lane >> 5;
  float GA[8], LA[8], GB[8], LB[8], mdum;
  StageRegs sr;
  { const int ja = __builtin_ctz(tilemask); const unsigned rest = tilemask & (tilemask - 1); const int jb = rest ? __builtin_ctz(rest) : ja;
    stage_load(sr, Kp, Vp, stride, ja, jb); }
  while (tilemask) {
    const int ja = __builtin_ctz(tilemask); tilemask &= tilemask - 1;
    const bool hasb = tilemask != 0; const int jb = hasb ? __builtin_ctz(tilemask) : ja; if (hasb) tilemask &= tilemask - 1;
    __syncthreads();
    stage_store(sr, lds);
    __syncthreads();
    if (tilemask) { const int na = __builtin_ctz(tilemask); const unsigned rest = tilemask & (tilemask - 1); const int nb = rest ? __builtin_ctz(rest) : na;
      stage_load(sr, Kp, Vp, stride, na, nb); }
    TileP ta, tb; bool ma = false, mb = false;
    { const int rel = t - ja * 64 - 4 * h; ta.j = ja; ta.lim_hi = 1000; ta.lim_lo = -100000; ta.rowbias = 0.f;
      if (ja == cur) { ta.lim_hi = rel; ma = true; }
      if (MODE == 1 && !((mysel >> ja) & 1u)) ta.rowbias = -1e30f;
      if (MODE == 2 && ja == cur - 8) { ta.lim_lo = rel - 511; ma = true; }
      if (MODE == 3 && ja == cur - 2) { ta.lim_lo = rel - 127; ma = true; } }
    { const int rel = t - jb * 64 - 4 * h; tb.j = jb; tb.lim_hi = 1000; tb.lim_lo = -100000; tb.rowbias = 0.f;
      if (jb == cur) { tb.lim_hi = rel; mb = true; }
      if (MODE == 1 && !((mysel >> jb) & 1u)) tb.rowbias = -1e30f;
      if (MODE == 2 && jb == cur - 8) { tb.lim_lo = rel - 511; mb = true; }
      if (MODE == 3 && jb == cur - 2) { tb.lim_lo = rel - 127; mb = true; } }
    if (hasb) {
      if (ma) { if (mb) pair_compute<MODE, true, true>(ta, tb, qf, slope2, t, o, m, l, GA, LA, GB, LB, mdum, lds);
                else pair_compute<MODE, true, false>(ta, tb, qf, slope2, t, o, m, l, GA, LA, GB, LB, mdum, lds); }
      else { if (mb) pair_compute<MODE, false, true>(ta, tb, qf, slope2, t, o, m, l, GA, LA, GB, LB, mdum, lds);
             else pair_compute<MODE, false, false>(ta, tb, qf, slope2, t, o, m, l, GA, LA, GB, LB, mdum, lds); }
    } else {
      if (ma) single_compute<MODE, true>(ta, qf, slope2, t, o, m, l, lds);
      else single_compute<MODE, false>(ta, qf, slope2, t, o, m, l, lds);
    }
  }
}

DI void zero_o(f32x16 (&o)[2]) {
#pragma unroll
  for (int i = 0; i < 16; ++i) { o[0][i] = 0.f; o[1][i] = 0.f; }
}
template <int STEP>
DI void y_step(f32x16 (&o)[2], const float sc, LAS unsigned char* lds) {
  const int tid = threadIdx.x, wid = tid >> 6, lane = tid & 63;
  LAS f32x4* yb = (LAS f32x4*)(lds + AL_IA) + (wid * 8) * 64 + lane;
#pragma unroll
  for (int db = 0; db < 2; ++db)
#pragma unroll
    for (int g4 = 0; g4 < 4; ++g4) {
      f32x4 v = {sc * o[db][4 * g4], sc * o[db][4 * g4 + 1], sc * o[db][4 * g4 + 2], sc * o[db][4 * g4 + 3]};
      LAS f32x4* s = yb + (db * 4 + g4) * 64;
      if (STEP >= 1) v = v + *s;
      if (STEP <= 1) *s = v;
      else { o[db][4 * g4] = v[0]; o[db][4 * g4 + 1] = v[1]; o[db][4 * g4 + 2] = v[2]; o[db][4 * g4 + 3] = v[3]; }
    }
}
DI void store_y(bf16_t* yrow, const f32x16 (&y)[2], int h) {
#pragma unroll
  for (int db = 0; db < 2; ++db)
#pragma unroll
    for (int g4 = 0; g4 < 4; ++g4) { u32x2 w; w.x = pk2(y[db][4 * g4], y[db][4 * g4 + 1]); w.y = pk2(y[db][4 * g4 + 2], y[db][4 * g4 + 3]);
      *(u32x2*)(yrow + db * 32 + 8 * g4 + 4 * h) = w; }
}

DI void swa_unit(const Params& p, int unit, LAS unsigned char* lds) {
  const int qt = unit & 31, g = (unit >> 5) & 1, b = unit >> 6;
  const int tid = threadIdx.x, wid = tid >> 6, lane = tid & 63, r = lane & 31, h = lane >> 5;
  const int hh = g * 4 + (wid >> 1), t = qt * 64 + (wid & 1) * 32 + r; const size_t row = (size_t)b * SEQ + t;
  const bf16_t* proj = (const bf16_t*)(p.ws + OFF_ACT);
  const float slope2 = fexp2(-(float)(hh + 1)) * LOG2E;
  bf16x8 qf[4];
  { const bf16_t* qp = proj + row * LDP + 1280 + hh * 64 + h * 8;
#pragma unroll
    for (int ks = 0; ks < 4; ++ks) qf[ks] = *(const bf16x8*)(qp + ks * 16); }
  f32x16 o[2]; zero_o(o); float m = -1e4f, l = 0.f;
  const int jlo = qt >= 2 ? qt - 2 : 0;
  const unsigned tmask = ((2u << qt) - 1u) & ~((1u << jlo) - 1u);
  const bf16_t* kvb = proj + (size_t)b * SEQ * LDP;
  attn_branch<3>(tmask, kvb + 1792 + g * 64, kvb + 1920 + g * 64, LDP, qf, slope2, t, qt, 0u, o, m, l, lds);
  float lt = l + __shfl_xor(l, 32);
  lt += fexp2(p.in[16][hh] * LOG2E - m);
  const float inv = frcp(lt);
#pragma unroll
  for (int i = 0; i < 16; ++i) { o[0][i] *= inv; o[1][i] *= inv; }
  store_y((bf16_t*)(p.ws + OFF_YB) + row * 512 + hh * 64, o, h);
  __syncthreads();
}

DI void nsa_unit(const Params& p, int unit, LAS unsigned char* lds) {
  const int qt = unit & 31, g = (unit >> 5) & 1, b = unit >> 6;
  const int tid = threadIdx.x, wid = tid >> 6, lane = tid & 63, r = lane & 31, h = lane >> 5;
  const int hr = wid >> 1, qloc = (wid & 1) * 32 + r, hh = g * 4 + hr, t = qt * 64 + qloc; const size_t row = (size_t)b * SEQ + t;
  const bf16_t* proj = (const bf16_t*)(p.ws + OFF_ACT);
  const float slope2 = fexp2(-(float)(hh + 1)) * LOG2E;
  bf16x8 qf[4];
  { const bf16_t* qp = proj + row * LDP + hh * 64 + h * 8;
#pragma unroll
    for (int ks = 0; ks < 4; ++ks) qf[ks] = *(const bf16x8*)(qp + ks * 16); }
  float gt0, gt1, gt2;
  { const bf16_t* gp = proj + row * LDP + 4096 + hh * 3; gt0 = sigm(bf2f(gp[0])); gt1 = sigm(bf2f(gp[1])); gt2 = sigm(bf2f(gp[2])); }
  if (tid == 0) *(LAS unsigned*)(lds + AL_UNI) = 0u;
  f32x16 o[2];
  float sc_cmp;
  {
    zero_o(o); float m = -1e4f, l = 0.f;
    const bf16_t* kc = (const bf16_t*)(p.ws + OFF_KC) + (size_t)(b * 2 + g) * 128 * 64;
    const bf16_t* vc = kc + (size_t)4096 * 64;
    const int nmax = t >= 31 ? ((t - 31) >> 4) : -1;
    float G0[8], L0[8], G1[8], L1[8], m0;
    StageRegs sr; stage_load(sr, kc, vc, 64, 0, 1);
    __syncthreads();
    stage_store(sr, lds);
    __syncthreads();
    TileP ta, tb; ta.j = 0; ta.lim_hi = nmax - 4 * h; ta.lim_lo = -100000; ta.rowbias = 0.f; tb.j = 1; tb.lim_hi = nmax - 64 - 4 * h; tb.lim_lo = -100000; tb.rowbias = 0.f;
    pair_compute<0, true, true>(ta, tb, qf, slope2, t, o, m, l, G0, L0, G1, L1, m0, lds);
    const float lt = l + __shfl_xor(l, 32);
    const float inv = lt > 0.f ? frcp(lt) : 0.f;
    const float f0 = fexp2(m0 - m) * inv, f1 = inv;
    LAS float* ia = (LAS float*)(lds + AL_IA) + (hr * 64 + qloc) * 33;
    LAS float* ib = (LAS float*)(lds + AL_IB) + (hr * 64 + qloc) * 33;
#pragma unroll
    for (int kb = 0; kb < 2; ++kb)
#pragma unroll
      for (int g4 = 0; g4 < 4; ++g4) {
        const int j0 = kb * 8 + 2 * g4 + h, j1 = 16 + j0;
        ia[j0] = G0[kb * 4 + g4] * f0; ib[j0 + 1] = L0[kb * 4 + g4] * f0;
        ia[j1] = G1[kb * 4 + g4] * f1; if (j1 < 31) ib[j1 + 1] = L1[kb * 4 + g4] * f1;
      }
    sc_cmp = gt0 * inv;
  }
  __syncthreads();
  {
    const int cur = qt, q = tid >> 3, part = tid & 7; unsigned mask;
    if (cur <= 7) mask = (2u << cur) - 1u;
    else {
      LAS float* ia = (LAS float*)(lds + AL_IA) + q * 33;
      LAS float* ib = (LAS float*)(lds + AL_IB) + q * 33;
      float v[4];
#pragma unroll
      for (int i = 0; i < 4; ++i) { const int j = part + 8 * i; float s = -2.f;
        if (j >= 1 && j <= cur - 2) { s = 0.f;
#pragma unroll
          for (int hd = 0; hd < 4; ++hd) s += ia[hd * 64 * 33 + j] + ib[hd * 64 * 33 + j]; }
        v[i] = s; }
      mask = 1u | (1u << cur) | (1u << (cur - 1));
#pragma unroll
      for (int k = 0; k < 5; ++k) {
        float best = v[0]; int bi = part;
#pragma unroll
        for (int i = 1; i < 4; ++i) if (v[i] > best) { best = v[i]; bi = part + 8 * i; }
#pragma unroll
        for (int sh = 1; sh < 8; sh <<= 1) { const float ob = __shfl_xor(best, sh); const int oi = __shfl_xor(bi, sh);
          if (ob > best || (ob == best && oi < bi)) { best = ob; bi = oi; } }
        mask |= 1u << bi;
#pragma unroll
        for (int i = 0; i < 4; ++i) if (bi == part + 8 * i) v[i] = -2.f;
      }
    }
    if (part == 0) { *((LAS unsigned*)(lds + AL_SEL) + q) = mask; atomicOr((unsigned*)(LAS unsigned*)(lds + AL_UNI), mask); }
  }
  __syncthreads();
  const unsigned mysel = *((LAS unsigned*)(lds + AL_SEL) + qloc);
  const unsigned uni = *(LAS unsigned*)(lds + AL_UNI);
  const bf16_t* kvb = proj + (size_t)b * SEQ * LDP;
  __syncthreads();
  y_step<0>(o, sc_cmp, lds);
  {
    zero_o(o); float m = -1e4f, l = 0.f;
    attn_branch<1>(uni & ((2u << qt) - 1u), kvb + 768 + g * 64, kvb + 896 + g * 64, LDP, qf, slope2, t, qt, mysel, o, m, l, lds);
    const float lt = l + __shfl_xor(l, 32); const float sc = gt1 * (lt > 0.f ? frcp(lt) : 0.f);
    y_step<1>(o, sc, lds);
  }
  {
    zero_o(o); float m = -1e4f, l = 0.f;
    const int jlo = qt >= 8 ? qt - 8 : 0;
    attn_branch<2>(((2u << qt) - 1u) & ~((1u << jlo) - 1u), kvb + 1024 + g * 64, kvb + 1152 + g * 64, LDP, qf, slope2, t, qt, 0u, o, m, l, lds);
    const float lt = l + __shfl_xor(l, 32); const float sc = gt2 * (lt > 0.f ? frcp(lt) : 0.f);
    y_step<2>(o, sc, lds);
  }
  store_y((bf16_t*)(p.ws + OFF_YA) + row * 512 + hh * 64, o, h);
  __syncthreads();
}

DI int rowmap(int n, int mode) {
  if (mode == 0) return n;
  if (mode == 1) return (n >> 7) * 256 + (n & 127);
  if (mode == 2) return (n >> 7) * 256 + 128 + (n & 127);
  return n < 1280 ? n : (n < 1304 ? 4096 + (n - 1280) : n - 24);
}
struct TrItem { const float* W; bf16_t* WT; int K, N, mode, k0, n0; };
constexpr int TR_LD = 261;
DI void tr_load(const TrItem& it, f32x4 (&v)[8]) {
  const int tid = otid(), c4 = (tid & 63) * 4, kr = tid >> 6;
#pragma unroll
  for (int i = 0; i < 8; ++i) { const int kk = kr + 8 * i;
    v[i] = (it.n0 + c4 < it.N) ? *(const f32x4*)(it.W + (size_t)(it.k0 + kk) * it.N + it.n0 + c4) : (f32x4){0.f, 0.f, 0.f, 0.f}; }
}
DI void tr_to_lds(const f32x4 (&v)[8], LAS unsigned char* lds) {
  const int tid = otid(), c4 = (tid & 63) * 4, kr = tid >> 6; LAS float* tile = (LAS float*)lds;
#pragma unroll
  for (int i = 0; i < 8; ++i) { LAS float* d = tile + (kr + 8 * i) * TR_LD + c4; d[0] = v[i][0]; d[1] = v[i][1]; d[2] = v[i][2]; d[3] = v[i][3]; }
}
DI void tr_store(const TrItem& it, LAS unsigned char* lds) {
  const int tid = otid(); LAS float* tile = (LAS float*)lds;
  const int ch = tid & 7;
#pragma unroll
  for (int i = 0; i < 4; ++i) { const int nn = (tid >> 3) + 64 * i; LAS float* s = tile + (ch * 8) * TR_LD + nn;
    u32x4 w; w.x = pk2(s[0], s[TR_LD]); w.y = pk2(s[2 * TR_LD], s[3 * TR_LD]); w.z = pk2(s[4 * TR_LD], s[5 * TR_LD]); w.w = pk2(s[6 * TR_LD], s[7 * TR_LD]);
    if (it.n0 + nn < it.N) *(u32x4*)(it.WT + (size_t)rowmap(it.n0 + nn, it.mode) * it.K + it.k0 + ch * 8) = w; }
}
DI void mod_item(const Params& p, int item, LAS unsigned char* lds) {
  const int tid = threadIdx.x, n0 = item * 64, kq = tid >> 6, nn = tid & 63;
  LAS float* sc = (LAS float*)lds;
  LAS float* red = (LAS float*)(lds + 65536);
  for (int e = tid; e < NB * DM; e += 512) sc[e] = silu_(p.in[1][e]);
  __syncthreads();
  float acc[16];
#pragma unroll
  for (int b = 0; b < 16; ++b) acc[b] = 0.f;
  const float* w = p.in[2] + (size_t)(kq * 128) * MODW + n0 + nn;
  for (int k = 0; k < 128; k += 4) { const float w0 = w[(size_t)k * MODW], w1 = w[(size_t)(k + 1) * MODW], w2 = w[(size_t)(k + 2) * MODW], w3 = w[(size_t)(k + 3) * MODW];
#pragma unroll
    for (int b = 0; b < 16; ++b) { const f32x4 s4 = *(const LAS f32x4*)(sc + b * DM + kq * 128 + k);
      acc[b] = __builtin_fmaf(s4[0], w0, acc[b]); acc[b] = __builtin_fmaf(s4[1], w1, acc[b]); acc[b] = __builtin_fmaf(s4[2], w2, acc[b]); acc[b] = __builtin_fmaf(s4[3], w3, acc[b]); } }
#pragma unroll
  for (int b = 0; b < 16; ++b) red[(kq * 16 + b) * 64 + nn] = acc[b];
  __syncthreads();
  float* mod = (float*)(p.ws + OFF_MOD);
  for (int e = tid; e < 1024; e += 512) { const int b = e >> 6, n = e & 63; float s = p.in[3][n0 + n];
#pragma unroll
    for (int q = 0; q < 8; ++q) s += red[(q * 16 + b) * 64 + n];
    mod[b * MODW + n0 + n] = s; }
  __syncthreads();
}
DI void phase0(const Params& p, LAS unsigned char* lds) {
  const int tid = otid(), bid = blockIdx.x, G = gridDim.x;
  for (int it = bid; it < 144; it += G) mod_item(p, it, lds);
  bf16_t* wgu1 = (bf16_t*)(p.ws + OFF_WGU1); bf16_t* wd1 = (bf16_t*)(p.ws + OFF_WD1); bf16_t* wgu2 = (bf16_t*)(p.ws + OFF_WGU2); bf16_t* wd2 = (bf16_t*)(p.ws + OFF_WD2);
  bf16_t* win = (bf16_t*)(p.ws + OFF_WIN); bf16_t* wupa = (bf16_t*)(p.ws + OFF_WUPA); bf16_t* wupb = (bf16_t*)(p.ws + OFF_WUPB); bf16_t* wout = (bf16_t*)(p.ws + OFF_WOUT);
  bf16_t* w1t = (bf16_t*)(p.ws + OFF_W1T);
  constexpr int I_G = 16 * 11, I_D = 44 * 4, I_IN = 16 * 17, I_UP = 8 * 4, I_OUT = 16 * 4, I_C = 32 * 1;
  constexpr int NIT = 4 * I_G + 2 * I_D + I_IN + 2 * I_UP + I_OUT + 2 * I_C;
  auto decode = [&](int it, TrItem& d) {
    int r = it; const float* W; bf16_t* WT; int K, N, mode;
    if (r < I_G) { W = p.in[5]; K = 1024; N = FF; WT = wgu1; mode = 1; }
    else if ((r -= I_G) < I_G) { W = p.in[6]; K = 1024; N = FF; WT = wgu1; mode = 2; }
    else if ((r -= I_G) < I_D) { W = p.in[7]; K = FF; N = 1024; WT = wd1; mode = 0; }
    else if ((r -= I_D) < I_G) { W = p.in[21]; K = 1024; N = FF; WT = wgu2; mode = 1; }
    else if ((r -= I_G) < I_G) { W = p.in[22]; K = 1024; N = FF; WT = wgu2; mode = 2; }
    else if ((r -= I_G) < I_D) { W = p.in[23]; K = FF; N = 1024; WT = wd2; mode = 0; }
    else if ((r -= I_D) < I_IN) { W = p.in[9]; K = 1024; N = INW; WT = win; mode = 3; }
    else if ((r -= I_IN) < I_UP) { W = p.in[17]; K = 512; N = 1024; WT = wupa; mode = 0; }
    else if ((r -= I_UP) < I_UP) { W = p.in[18]; K = 512; N = 1024; WT = wupb; mode = 0; }
    else if ((r -= I_UP) < I_OUT) { W = p.in[19]; K = 1024; N = 1024; WT = wout; mode = 0; }
    else if ((r -= I_OUT) < I_C) { W = p.in[11]; K = 2048; N = 256; WT = w1t; mode = 0; }
    else { r -= I_C; W = p.in[14]; K = 2048; N = 256; WT = w1t + (size_t)256 * 2048; mode = 0; }
    const int ntn = (N + 255) >> 8;
    d.W = W; d.WT = WT; d.K = K; d.N = N; d.mode = mode; d.k0 = (r / ntn) * 64; d.n0 = (r % ntn) * 256;
  };
  {
    f32x4 v[8]; TrItem cur, nxt;
    int it = bid;
    if (it < NIT) { decode(it, cur); tr_load(cur, v); }
    while (it < NIT) {
      tr_to_lds(v, lds);
      __syncthreads();
      const int itn = it + G;
      if (itn < NIT) { decode(itn, nxt); tr_load(nxt, v); }
      tr_store(cur, lds);
      __syncthreads();
      cur = nxt; it = itn;
    }
  }
  { const int gt = bid * 512 + tid, gs = G * 512;
    const u32x4 z = {0u, 0u, 0u, 0u};
    u32x4* zp = (u32x4*)(win + (size_t)INW * 1024);
    for (int e = gt; e < (LDP - INW) * 1024 / 8; e += gs) zp[e] = z;
    if (bid == 0) ((u32x4*)(p.ws + OFF_KVC + 2 * SZ_KVC1 * 2))[tid] = z; }
  if (bid >= G - 16) {
    const int w = bid - (G - 16), kv = w >> 3, hd = (w & 7) * 32 + (tid & 31), kq = tid >> 5;
    const float* pos = p.in[kv ? 13 : 10]; const float* w1 = p.in[kv ? 14 : 11];
    float s = 0.f;
    for (int k = kq * 128; k < kq * 128 + 128; ++k) s = __builtin_fmaf(pos[k], w1[(size_t)k * 256 + hd], s);
    LAS float* red = (LAS float*)lds;
    __syncthreads();
    red[tid] = s;
    __syncthreads();
    if (tid < 32) { float a = 0.f;
#pragma unroll
      for (int q = 0; q < 16; ++q) a += red[q * 32 + tid];
      ((float*)(p.ws + OFF_CB))[kv * 256 + hd] = a; }
    __syncthreads();
  }
}
DI void norm_mod_phase(const float* X, bf16_t* U, const float* g, const float* mod, int sh_off, int sc_off, int nwg) {
  const int tid_ = otid(), lane = tid_ & 63, gw = blockIdx.x * 8 + (tid_ >> 6), NW = nwg * 8;
  for (int row = gw; row < MTOK; row += NW) {
    const int b = row >> 11; const f32x4* xr = (const f32x4*)(X + (size_t)row * DM) + lane;
    f32x4 v[4]; float ss = 0.f;
#pragma unroll
    for (int j = 0; j < 4; ++j) { v[j] = xr[64 * j]; ss += (v[j][0] * v[j][0] + v[j][1] * v[j][1]) + (v[j][2] * v[j][2] + v[j][3] * v[j][3]); }
    const float rs = 1.0f / sqrtf(wave_sum(ss) * (1.f / DM) + 1e-6f);
    u32x2* o = (u32x2*)(U + (size_t)row * DM) + lane;
#pragma unroll
    for (int j = 0; j < 4; ++j) { const int col = lane * 4 + 256 * j;
      const f32x4 gg = *(const f32x4*)(g + col), sh = *(const f32x4*)(mod + b * MODW + sh_off + col), sc = *(const f32x4*)(mod + b * MODW + sc_off + col);
      const f32x4 u = (v[j] * rs) * gg * (1.f + sc) + sh;
      u32x2 w; w.x = pk2(u[0], u[1]); w.y = pk2(u[2], u[3]); o[64 * j] = w; }
  }
}
DI void final_norm_phase(float* X, const float* g) {
  const int tid_ = otid(), lane = tid_ & 63, gw = blockIdx.x * 8 + (tid_ >> 6), NW = gridDim.x * 8;
  for (int row = gw; row < MTOK; row += NW) {
    f32x4* xr = (f32x4*)(X + (size_t)row * DM) + lane;
    f32x4 v[4]; float ss = 0.f;
#pragma unroll
    for (int j = 0; j < 4; ++j) { v[j] = xr[64 * j]; ss += (v[j][0] * v[j][0] + v[j][1] * v[j][1]) + (v[j][2] * v[j][2] + v[j][3] * v[j][3]); }
    const float rs = 1.0f / sqrtf(wave_sum(ss) * (1.f / DM) + 1e-6f);
#pragma unroll
    for (int j = 0; j < 4; ++j) { const f32x4 gg = *(const f32x4*)(g + lane * 4 + 256 * j); xr[64 * j] = (v[j] * rs) * gg; }
  }
}
DI void final_scale_phase(const bf16_t* HG, const float* ps, float* out) {
  const int tid_ = otid(), lane = tid_ & 63, gw = blockIdx.x * 8 + (tid_ >> 6), NW = gridDim.x * 8;
  for (int row = gw; row < MTOK; row += NW) {
    const float rs = row_rs(ps, row);
    const u32x4* hr = (const u32x4*)(HG + (size_t)row * DM) + lane; f32x4* o = (f32x4*)(out + (size_t)row * DM) + 2 * lane;
#pragma unroll
    for (int j = 0; j < 2; ++j) { const u32x4 w = hr[64 * j];
      f32x4 a = {bflo(w.x), bfhi(w.x), bflo(w.y), bfhi(w.y)}, b = {bflo(w.z), bfhi(w.z), bflo(w.w), bfhi(w.w)};
      o[128 * j] = a * rs; o[128 * j + 1] = b * rs; }
  }
}
DI void cmp2_phase(const Params& p, LAS unsigned char* lds) {
  const int tid = otid(), lane = tid & 63, wid = tid >> 6;
  const bf16_t* hid = (const bf16_t*)(p.ws + OFF_HID); bf16_t* kc = (bf16_t*)(p.ws + OFF_KC);
  LAS float* w2s = (LAS float*)lds; LAS unsigned char* hids = lds + 65536;
  for (int it = blockIdx.x; it < 256; it += gridDim.x) {
    const int row0 = it * 32, kv = row0 >> 12; const float* w2 = p.in[kv ? 15 : 12];
#pragma unroll
    for (int i = 0; i < 8; ++i) ((LAS f32x4*)w2s)[tid + 512 * i] = ((const f32x4*)w2)[tid + 512 * i];
#pragma unroll
    for (int i = 0; i < 2; ++i) ((LAS u32x4*)hids)[tid + 512 * i] = ((const u32x4*)(hid + (size_t)row0 * 256))[tid + 512 * i];
    __syncthreads();
    float acc[4] = {0.f, 0.f, 0.f, 0.f};
    for (int k8 = 0; k8 < 32; ++k8) {
      u32x4 hv[4];
#pragma unroll
      for (int rr = 0; rr < 4; ++rr) hv[rr] = *(const LAS u32x4*)(hids + ((wid * 4 + rr) * 256 + k8 * 8) * 2);
      float w[8];
#pragma unroll
      for (int e = 0; e < 8; ++e) w[e] = w2s[(k8 * 8 + e) * 64 + lane];
#pragma unroll
      for (int rr = 0; rr < 4; ++rr) {
        acc[rr] = __builtin_fmaf(bflo(hv[rr].x), w[0], acc[rr]); acc[rr] = __builtin_fmaf(bfhi(hv[rr].x), w[1], acc[rr]);
        acc[rr] = __builtin_fmaf(bflo(hv[rr].y), w[2], acc[rr]); acc[rr] = __builtin_fmaf(bfhi(hv[rr].y), w[3], acc[rr]);
        acc[rr] = __builtin_fmaf(bflo(hv[rr].z), w[4], acc[rr]); acc[rr] = __builtin_fmaf(bfhi(hv[rr].z), w[5], acc[rr]);
        acc[rr] = __builtin_fmaf(bflo(hv[rr].w), w[6], acc[rr]); acc[rr] = __builtin_fmaf(bfhi(hv[rr].w), w[7], acc[rr]);
      }
    }
#pragma unroll
    for (int rr = 0; rr < 4; ++rr) { const float s1 = __shfl_down(acc[rr], 1);
      if (!(lane & 1)) *(unsigned*)(kc + (size_t)(row0 + wid * 4 + rr) * 64 + lane) = pk2(acc[rr], s1); }
    __syncthreads();
  }
}

#define XB_TMO      128
#define XB_XCNT(j)  (256  + 64 * (j))
#define XB_XSUB(j)  (1280 + 64 * (j))
#define XB_XGEN(j)  (2304 + 64 * (j))
#define XB_TOP      3328
#define XB_TOPGEN   3392
#define XCD_BAR_WORDS 3456
#define XB_SPIN_CAP (1u << 18)
DI unsigned xb_ld(unsigned* p) { return __hip_atomic_load(p, __ATOMIC_RELAXED, __HIP_MEMORY_SCOPE_AGENT); }
DI unsigned xb_add(unsigned* p, unsigned v) { return __hip_atomic_fetch_add(p, v, __ATOMIC_RELAXED, __HIP_MEMORY_SCOPE_AGENT); }
DI unsigned xb_xcc_id() { return (unsigned)__builtin_amdgcn_s_getreg((3 << 11) | 20) & 0xFu; }
#define XB_SPIN(cond, bar) do { unsigned _sp = 0; while (cond) { __builtin_amdgcn_s_sleep(1); \
    if ((++_sp & 255u) == 0u) { if (xb_ld(&(bar)[XB_TMO])) break; if (_sp > XB_SPIN_CAP) { atomicAdd(&(bar)[XB_TMO], 1u); break; } } } } while (0)
struct XcdBarrier { unsigned* bar; unsigned x; volatile LAS unsigned* st; };
DI XcdBarrier xcd_barrier_post(unsigned* bar, volatile LAS unsigned* st) {
  XcdBarrier b; b.bar = bar; b.x = xb_xcc_id(); b.st = st;
  if (threadIdx.x == 0) (void)xb_add(&bar[XB_XCNT(b.x)], 1u);
  return b;
}
DI void xcd_barrier_complete(unsigned* bar, unsigned x, unsigned& nloc, unsigned& nx) {
  const unsigned G = gridDim.x * gridDim.y * gridDim.z;
  unsigned sum, cnt, mine, sp = 0u;
  for (;;) {
    sum = 0u; cnt = 0u; mine = 0u;
#pragma unroll
    for (unsigned j = 0; j < 16; ++j) { const unsigned c = xb_ld(&bar[XB_XCNT(j)]); sum += c; cnt += (c > 0u) ? 1u : 0u; mine = (j == x) ? c : mine; }
    if (sum == G) break;
    __builtin_amdgcn_s_sleep(1);
    if ((++sp & 255u) == 0u) { if (xb_ld(&bar[XB_TMO])) break; if (sp > XB_SPIN_CAP) { atomicAdd(&bar[XB_TMO], 1u); break; } }
  }
  nloc = mine > 0u ? mine : 1u; nx = cnt > 0u ? cnt : 1u;
}
DI void xcd_barrier(const XcdBarrier& b) {
  asm volatile("s_waitcnt vmcnt(0)" ::: "memory");
  __syncthreads();
  if (threadIdx.x == 0) {
    unsigned* bar = b.bar;
    __builtin_amdgcn_s_waitcnt(0);
    unsigned nloc = b.st[0], nx = b.st[1];
    if (nloc == 0u) { xcd_barrier_complete(bar, b.x, nloc, nx); b.st[0] = nloc; b.st[1] = nx; }
    const unsigned old = xb_add(&bar[XB_XSUB(b.x)], 1u);
    const unsigned gen = old / nloc;
    if (old + 1u == (gen + 1u) * nloc) {
      __builtin_amdgcn_fence(__ATOMIC_RELEASE, "agent");
      asm volatile("s_waitcnt vmcnt(0)" ::: "memory");
      const unsigned og = xb_add(&bar[XB_TOP], 1u);
      const unsigned tg = og / nx;
      if (og + 1u == (tg + 1u) * nx) xb_add(&bar[XB_TOPGEN], 1u);
      else XB_SPIN(xb_ld(&bar[XB_TOPGEN]) == tg, bar);
      __builtin_amdgcn_fence(__ATOMIC_ACQUIRE, "agent");
      xb_add(&bar[XB_XGEN(b.x)], 1u);
      asm volatile("s_waitcnt vmcnt(0)" ::: "memory");
    } else {
      XB_SPIN(xb_ld(&bar[XB_XGEN(b.x)]) == gen, bar);
      __builtin_amdgcn_fence(__ATOMIC_ACQUIRE, "agent");
      asm volatile("s_waitcnt vmcnt(0)" ::: "memory");
    }
  }
  __syncthreads();
}

extern __shared__ __attribute__((aligned(16))) unsigned char dyn_lds[];
constexpr int LDS_BYTES = 8 * HT_B + 16;
constexpr int NPHASE = 15;

__global__ void __launch_bounds__(512) mega(Params p) {
  LAS unsigned char* lds = (LAS unsigned char*)dyn_lds;
  cg::grid_group grid = cg::this_grid();
  const float* mod = (const float*)(p.ws + OFF_MOD);
  bf16_t* U = (bf16_t*)(p.ws + OFF_U); bf16_t* ACT = (bf16_t*)(p.ws + OFF_ACT);
#ifndef DUPMASK
#define DUPMASK 0
#endif
  if (p.ph_lo < 0) grid.sync();
  if (threadIdx.x == 0) { *(volatile LAS unsigned*)(lds + 8 * HT_B) = 0u; *(volatile LAS unsigned*)(lds + 8 * HT_B + 4) = 0u; }
  __syncthreads();
  (void)xcd_barrier_post((unsigned*)(p.ws + OFF_BAR), (volatile LAS unsigned*)(lds + 8 * HT_B));
#define GSYNC() do { unsigned* _bw = (unsigned*)(p.ws + OFF_BAR); asm volatile("" : "+s"(_bw)); XcdBarrier _xb; _xb.bar = _bw; _xb.x = xb_xcc_id(); _xb.st = (volatile LAS unsigned*)(lds + 8 * HT_B); xcd_barrier(_xb); } while (0)
#define PH_BEGIN(n) if (p.ph_lo <= (n) && (n) < p.ph_hi) { for (int rep = 0; rep < 1 + ((DUPMASK >> (n)) & 1); ++rep) { if (rep) GSYNC();
#define PH_END(n) } if ((n) + 1 < p.ph_hi) GSYNC(); }
  PH_BEGIN(0) phase0(p, lds); PH_END(0)
  float* PS = (float*)(p.ws + OFF_PS); float* GT = (float*)(p.ws + OFF_GT); float* SHW2 = (float*)(p.ws + OFF_SHW2); float* SHW3 = (float*)(p.ws + OFF_SHW3);
  bf16_t* HB = (bf16_t*)p.out;
  bf16_t* U3 = (bf16_t*)(p.ws + OFF_YA);
  PH_BEGIN(1)
    const int G1 = gridDim.x, nsh = (G1 > 2 * NSHU) ? NSHU : 0, nwg = G1 - nsh;
    if ((int)blockIdx.x >= nwg) {
      const int tid = otid(), w = blockIdx.x - nwg; const bool second = w >= 17; const int pn = second ? w - 17 : w;
      bf16_t* slot = (bf16_t*)(p.ws + OFF_SH) + (size_t)w * 256 * 1024;
      { const int b = tid >> 5, k0 = (tid & 31) * 32; const float* s = mod + (second ? 6144 : 3072) + b * MODW + k0; bf16_t* d = slot + b * 1024 + k0;
#pragma unroll
        for (int i = 0; i < 4; ++i) { const f32x4 x0 = *(const f32x4*)(s + 8 * i), x1 = *(const f32x4*)(s + 8 * i + 4);
          u32x4 wv; wv.x = pk2(x0[0], x0[1]); wv.y = pk2(x0[2], x0[3]); wv.z = pk2(x1[0], x1[1]); wv.w = pk2(x1[2], x1[3]); *(u32x4*)(d + 8 * i) = wv; } }
      asm volatile("s_waitcnt vmcnt(0)" ::: "memory");
      __syncthreads();
      gemm_stream(OneUnit{slot, (const bf16_t*)(p.ws + (second ? OFF_WGU2 : OFF_WIN)) + (size_t)pn * 256 * 1024, pn * 256}, 1024, 1024, 1024, EpiShW{second ? SHW3 : SHW2, second ? 5632 : LDP}, lds);
    } else {
      { const int tid = otid();
        for (int e = blockIdx.x * 512 + tid; e < 3 * NB * DM; e += nwg * 512) { const int which = e >> 14, b = (e >> 10) & 15, col = e & 1023;
          GT[e] = which == 2 ? p.in[24][col] : p.in[which ? 20 : 8][col] * (1.f + mod[b * MODW + (which ? 7168 : 4096) + col]); } }
      norm_mod_phase(p.in[0], U, p.in[4], mod, 0, 1024, nwg);
    }
  PH_END(1)
  PH_BEGIN(2) gemm_stream(StdUnits{U, 1024, (const bf16_t*)(p.ws + OFF_WGU1), 1024, 128, 22}, 1024, 1024, 1024, EpiGU<false>{ACT, nullptr, nullptr}, lds); PH_END(2)
#ifdef DUP2
  gemm_stream(StdUnits{U, 1024, (const bf16_t*)(p.ws + OFF_WGU1), 1024, 128, 22}, 1024, 1024, 1024, EpiGU<false>{ACT, nullptr, nullptr}, lds); GSYNC();
#endif
  PH_BEGIN(3) gemm_stream(StdUnits{ACT, FF, (const bf16_t*)(p.ws + OFF_WD1), FF, 128, 4}, FF, FF, FF, EpiResN<false, true, 1>{p.in[0], HB, mod + 2048, GT, U, PS}, lds); PH_END(3)
  PH_BEGIN(5) gemm_stream(StdUnits{U, 1024, (const bf16_t*)(p.ws + OFF_WIN), 1024, 128, 17}, 1024, 1024, 1024, EpiProj{ACT, (bf16_t*)(p.ws + OFF_KVC), PS, SHW2}, lds); PH_END(5)
  PH_BEGIN(6)
    gemm_stream(CmpUnits{(const bf16_t*)(p.ws + OFF_KVC), (const bf16_t*)(p.ws + OFF_W1T)}, 1024, 2048, 2048, EpiHid2{(bf16_t*)(p.ws + OFF_HID), (const float*)(p.ws + OFF_CB)}, lds);
    if (gridDim.x > 64) { if (blockIdx.x >= 32) for (int it = blockIdx.x - 32; it < 1024; it += gridDim.x - 32) swa_unit(p, it, lds); }
    else for (int it = blockIdx.x; it < 1024; it += gridDim.x) swa_unit(p, it, lds);
  PH_END(6)
  PH_BEGIN(7) cmp2_phase(p, lds); PH_END(7)
  PH_BEGIN(8)
    if (gridDim.x == 256) {
      const int w = blockIdx.x, q = w & 31, hi = w >> 5;
      for (int k = 0; k < 4; ++k) { const int q2 = (k & 2) ? ((q + 16) & 31) : q, qt = (k & 1) ? 31 - q2 : q2, bg = hi * 4 + k;
        nsa_unit(p, (bg << 5) | qt, lds); }
    } else for (int it = blockIdx.x; it < 1024; it += gridDim.x) nsa_unit(p, it, lds);
  PH_END(8)
  PH_BEGIN(9)
    gemm_stream(UpUnits{(const bf16_t*)(p.ws + OFF_YA), (const bf16_t*)(p.ws + OFF_YB), (const bf16_t*)(p.ws + OFF_WUPA), (const bf16_t*)(p.ws + OFF_WUPB)}, 512, 512, 512, EpiUp{ACT, U}, lds);
  PH_END(9)
  PH_BEGIN(10) gemm_stream(StdUnits{U, 1024, (const bf16_t*)(p.ws + OFF_WOUT), 1024, 128, 4}, 1024, 1024, 1024, EpiResN<true, true, 2>{HB, HB, mod + 5 * 1024, GT + NB * DM, U3, PS}, lds); PH_END(10)
  PH_BEGIN(12) gemm_stream(StdUnits{U3, 1024, (const bf16_t*)(p.ws + OFF_WGU2), 1024, 128, 22}, 1024, 1024, 1024, EpiGU<true>{ACT, PS, SHW3}, lds); PH_END(12)
  PH_BEGIN(13) gemm_stream(StdUnits{ACT, FF, (const bf16_t*)(p.ws + OFF_WD2), FF, 128, 4}, FF, FF, FF, EpiResN<true, false, 1>{HB, nullptr, mod + 8 * 1024, GT + 2 * NB * DM, U, PS}, lds); PH_END(13)
  PH_BEGIN(14) final_scale_phase(U, PS, p.out); PH_END(14)
}

extern "C" void kernel_launch(void* const* d_in, const int* in_sizes, int n_in, void* d_out, int out_size, void* d_ws, size_t ws_size, hipStream_t stream) {
  static int grid = 0;
  if (grid == 0) {
    if (n_in != 25 || out_size != MTOK * DM || ws_size < WS_END) { fprintf(stderr, "kernel_launch: unexpected shapes (n_in %d out %d ws %zu need %zu)\n", n_in, out_size, ws_size, (size_t)WS_END); grid = -1; return; }
    int dev = 0, cus = 0, per_cu = 0;
    hipGetDevice(&dev);
    hipDeviceGetAttribute(&cus, hipDeviceAttributeMultiprocessorCount, dev);
    hipFuncSetAttribute((const void*)mega, hipFuncAttributeMaxDynamicSharedMemorySize, LDS_BYTES);
    hipOccupancyMaxActiveBlocksPerMultiprocessor(&per_cu, (const void*)mega, 512, LDS_BYTES);
    if (per_cu < 1) { fprintf(stderr, "kernel_launch: occupancy query reports %d blocks per CU\n", per_cu); grid = -1; return; }
    grid = cus;
  }
  if (grid < 0) return;
  if (hipMemsetAsync((char*)d_ws + OFF_BAR, 0, XCD_BAR_WORDS * 4, stream) != hipSuccess) { fprintf(stderr, "kernel_launch: memset of the barrier words failed\n"); return; }
  Params p{};
  for (int i = 0; i < 25; ++i) p.in[i] = (const float*)d_in[i];
  p.out = (float*)d_out; p.ws = (unsigned char*)d_ws;
#if NLAUNCH == 1
  p.ph_lo = 0; p.ph_hi = NPHASE;
  void* args[] = {&p};
  hipError_t e = hipLaunchCooperativeKernel((const void*)mega, dim3(grid), dim3(512), args, LDS_BYTES, stream);
  if (e != hipSuccess) fprintf(stderr, "cooperative launch failed: %s (grid %d)\n", hipGetErrorString(e), grid);
#else
  for (int ph = 0; ph < NPHASE; ++ph) {
    p.ph_lo = ph; p.ph_hi = ph + 1;
    void* args[] = {&p};
    hipError_t e = hipLaunchCooperativeKernel((const void*)mega, dim3(grid), dim3(512), args, LDS_BYTES, stream);
    if (e != hipSuccess) { fprintf(stderr, "launch of phase %d failed: %s\n", ph, hipGetErrorString(e)); break; }
  }
#endif
}
```

```cpp
#include <hip/hip_runtime.h>
#include <hip/hip_cooperative_groups.h>
#include <cstdio>
#include <cstdint>
namespace cg = cooperative_groups;

#ifndef NLAUNCH
#define NLAUNCH 1
#endif

#define DI __device__ __forceinline__
#define LAS __attribute__((address_space(3)))
typedef unsigned short bf16_t;
typedef short bf16x8 __attribute__((ext_vector_type(8)));
typedef short s16x4 __attribute__((ext_vector_type(4)));
typedef float f32x2 __attribute__((ext_vector_type(2)));
typedef float f32x4 __attribute__((ext_vector_type(4)));
typedef float f32x16 __attribute__((ext_vector_type(16)));
typedef unsigned u32x2 __attribute__((ext_vector_type(2)));
typedef unsigned u32x4 __attribute__((ext_vector_type(4)));
typedef __bf16 bf16v2 __attribute__((ext_vector_type(2)));

constexpr int NB = 16, SEQ = 2048, DM = 1024, MTOK = NB * SEQ, FF = 2816, LDP = 4352, INW = 4120, MODW = 9216;
constexpr float LOG2E = 1.4426950408889634f;
constexpr float C1 = 0.125f * LOG2E;

constexpr size_t SZ_WGU = (size_t)5632 * 1024 * 2, SZ_WD = (size_t)1024 * 2816 * 2;
constexpr size_t OFF_WGU1 = 0;
constexpr size_t OFF_WD1 = OFF_WGU1 + SZ_WGU;
constexpr size_t OFF_WGU2 = OFF_WD1 + SZ_WD;
constexpr size_t OFF_WD2 = OFF_WGU2 + SZ_WGU;
constexpr size_t OFF_WIN = OFF_WD2 + SZ_WD;
constexpr size_t OFF_WUPA = OFF_WIN + (size_t)LDP * 1024 * 2;
constexpr size_t OFF_WUPB = OFF_WUPA + (size_t)1024 * 512 * 2;
constexpr size_t OFF_WOUT = OFF_WUPB + (size_t)1024 * 512 * 2;
constexpr size_t OFF_W1T = OFF_WOUT + (size_t)1024 * 1024 * 2;
constexpr size_t OFF_MOD = OFF_W1T + (size_t)2 * 256 * 2048 * 2;
constexpr size_t OFF_CB = OFF_MOD + (size_t)NB * MODW * 4;
constexpr size_t OFF_U = OFF_CB + 4096;
constexpr size_t OFF_ACT = OFF_U + (size_t)MTOK * 1024 * 2;
constexpr size_t OFF_YA = OFF_ACT + (size_t)MTOK * LDP * 2;
constexpr size_t OFF_YB = OFF_YA + (size_t)MTOK * 512 * 2;
constexpr size_t OFF_KVC = OFF_YB + (size_t)MTOK * 512 * 2;
constexpr size_t SZ_KVC1 = (size_t)NB * 2 * SEQ * 64;
constexpr size_t OFF_HID = OFF_KVC + 2 * SZ_KVC1 * 2 + 8192;
constexpr size_t OFF_KC = OFF_HID + (size_t)2 * 4096 * 256 * 2;
constexpr size_t OFF_GT = OFF_KC + (size_t)2 * 4096 * 64 * 2;
constexpr size_t OFF_SHW2 = OFF_GT + (size_t)3 * NB * DM * 4;
constexpr size_t OFF_SHW3 = OFF_SHW2 + (size_t)NB * LDP * 4;
constexpr size_t OFF_PS = OFF_SHW3 + (size_t)NB * 5632 * 4;
constexpr size_t OFF_SH = OFF_PS + (size_t)MTOK * 16 * 4;
constexpr int NSHU = 17 + 22;
constexpr size_t OFF_BAR = OFF_SH + (size_t)NSHU * 256 * 1024 * 2;
constexpr size_t WS_END = OFF_BAR + 16384;

struct Params {
  const float* in[25];
  float* out;
  unsigned char* ws;
  int ph_lo, ph_hi;
};

DI unsigned pk2(float lo, float hi) { bf16v2 v = __builtin_convertvector((f32x2){lo, hi}, bf16v2); return __builtin_bit_cast(unsigned, v); }
DI float bf2f(unsigned short v) { return __uint_as_float((unsigned)v << 16); }
DI float bflo(unsigned v) { return __uint_as_float(v << 16); }
DI float bfhi(unsigned v) { return __uint_as_float(v & 0xffff0000u); }
DI float fexp2(float x) { return __builtin_amdgcn_exp2f(x); }
DI float frcp(float x) { return __builtin_amdgcn_rcpf(x); }
DI float sigm(float x) { return frcp(1.f + fexp2(-LOG2E * x)); }
DI float silu_(float x) { return x * sigm(x); }
DI float gelu_tanh(float x) { const float z = 0.7978845608f * (x + 0.044715f * x * x * x); return x * sigm(2.f * z); }
DI int otid() { int t = threadIdx.x; asm volatile("" : "+v"(t)); return t; }
DI float wave_sum(float v) {
#pragma unroll
  for (int o = 1; o < 64; o <<= 1) v += __shfl_xor(v, o);
  return v;
}

constexpr int HT_B = 128 * 64 * 2;
DI int lds_byte(int r, int c) { const int st = (r >> 4) * 2 + (c >> 5), rr = r & 15, cc = c & 31, ob = rr * 64 + cc * 2; return st * 1024 + (ob ^ (((ob >> 9) & 1) << 5)); }
DI void stage_rc(int b, int& R, int& C) { const int st = b / 1024, sb = b % 1024, swz = sb ^ (((sb >> 9) & 1) << 5); R = (st >> 1) * 16 + swz / 64; C = (st & 1) * 32 + (swz % 64) / 2; }
DI int perm32(int rho) { const int n = rho >> 4, i = rho & 15; return 8 * (i >> 2) + 4 * n + (i & 3); }

struct UnitD { const bf16_t* a; const bf16_t* b; int brow, bcol, aux; };
DI bool unit_of(int L, int nM, int nN, int& pm, int& pn) {
  const int nwg = nM * nN; if (L >= nwg) return false;
  int wgid = L; { const int q = nwg / 8, r = nwg % 8, xcd = wgid % 8, off = wgid / 8; wgid = (xcd < r ? xcd * (q + 1) : r * (q + 1) + (xcd - r) * q) + off; }
  const int nig = 8 * nN, gid = wgid / nig, fm = gid * 8, gsz = (nM - fm) < 8 ? (nM - fm) : 8;
  pm = fm + ((wgid % nig) % gsz); pn = (wgid % nig) / gsz; return true;
}
struct StdUnits { const bf16_t* A; int lda; const bf16_t* Bt; int ldb; int nM, nN;
  DI bool next(int i, UnitD& d) const { int pm, pn; if (!unit_of(i * (int)gridDim.x + (int)blockIdx.x, nM, nN, pm, pn)) return false;
    d.brow = pm * 256; d.bcol = pn * 256; d.aux = 0; d.a = A + (size_t)d.brow * lda; d.b = Bt + (size_t)d.bcol * ldb; return true; } };

#define EPI_ARGS const f32x4 (&acc)[2][2][4][2], int brow, int bcol, int aux, int wr, int wc, int fr, int fq
template <class Units, class Epi>
DI void gemm_stream(const Units& S, const int lda, const int ldb, const int K, const Epi& epi, LAS unsigned char* lds) {
  const int tid = threadIdx.x, wid = __builtin_amdgcn_readfirstlane(tid >> 6), lane = tid & 63, wr = wid >> 2, wc = wid & 3, fr = lane & 15, fq = lane >> 4;
  const int nt = K / 64;
  int R, C; stage_rc(tid * 16, R, C);
  const size_t offA = (size_t)R * lda + C, offB = (size_t)((R & ~31) + perm32(R & 31)) * ldb + C;
  const size_t a64 = (size_t)64 * lda, b64 = (size_t)64 * ldb, ah = (size_t)128 * lda, bh = (size_t)128 * ldb;
  const unsigned ldsw = (unsigned)wid * 1024u;
  const int aoff = lds_byte(wr * 64 + fr, fq * 8), boff = lds_byte(wc * 32 + fr, fq * 8);
#define G_SA(b, h) (((b) * 2 + (h)) * HT_B)
#define G_SB(b, h) ((4 + (b) * 2 + (h)) * HT_B)
#define G_STAGE(bufoff, gp, st64) do { const bf16_t* _g = (gp); \
    __builtin_amdgcn_global_load_lds((const unsigned*)_g, (LAS unsigned*)(lds + (bufoff) + ldsw), 16, 0, 0); \
    __builtin_amdgcn_global_load_lds((const unsigned*)(_g + (st64)), (LAS unsigned*)(lds + (bufoff) + ldsw + 8192), 16, 0, 0); } while (0)
#define G_LDA(dst, b, h) do { _Pragma("unroll") for (int m = 0; m < 4; ++m) _Pragma("unroll") for (int k = 0; k < 2; ++k) dst[m][k] = *(const LAS bf16x8*)(lds + G_SA(b, h) + aoff + m * 2048 + k * 1024); } while (0)
#define G_LDB(dst, b, h) do { _Pragma("unroll") for (int n = 0; n < 2; ++n) _Pragma("unroll") for (int k = 0; k < 2; ++k) dst[n][k] = *(const LAS bf16x8*)(lds + G_SB(b, h) + boff + n * 2048 + k * 1024); } while (0)
#define G_MMA(ai, bj, At, Bq) do { __builtin_amdgcn_s_setprio(1); _Pragma("unroll") for (int m = 0; m < 4; ++m) _Pragma("unroll") for (int n = 0; n < 2; ++n) _Pragma("unroll") for (int k = 0; k < 2; ++k) \
    acc[ai][bj][m][n] = __builtin_amdgcn_mfma_f32_16x16x32_bf16(Bq[n][k], At[m][k], acc[ai][bj][m][n], 0, 0, 0); __builtin_amdgcn_s_setprio(0); } while (0)
#define WAIT_V(n) asm volatile("s_waitcnt vmcnt(" #n ")" ::: "memory")
#define WAIT_L(n) asm volatile("s_waitcnt lgkmcnt(" #n ")" ::: "memory")
#define BAR __builtin_amdgcn_s_barrier()
#define SCHED __builtin_amdgcn_sched_barrier(0)
  UnitD cur, nxt; int ui = 0;
  if (!S.next(0, cur)) return;
  f32x4 acc[2][2][4][2];
#pragma unroll
  for (int a = 0; a < 2; ++a)
#pragma unroll
    for (int b = 0; b < 2; ++b)
#pragma unroll
      for (int m = 0; m < 4; ++m)
#pragma unroll
        for (int n = 0; n < 2; ++n) acc[a][b][m][n] = (f32x4){0.f, 0.f, 0.f, 0.f};
  bf16x8 At[4][2], B0[2][2], B1[2][2];
  const bf16_t* cA = cur.a + offA; const bf16_t* cB = cur.b + offB;
  G_STAGE(G_SB(0, 0), cB, b64); G_STAGE(G_SB(0, 1), cB + bh, b64); G_STAGE(G_SA(0, 0), cA, a64); G_STAGE(G_SA(0, 1), cA + ah, a64);
  if (wr == 1) BAR;
  WAIT_V(2); BAR;
  G_STAGE(G_SB(1, 0), cB + 64, b64); G_STAGE(G_SA(1, 0), cA + 64, a64); G_STAGE(G_SB(1, 1), cB + bh + 64, b64);
  WAIT_V(6); BAR;
  for (;;) {
    const bool has_next = S.next(ui + 1, nxt);
    const bf16_t* nA = has_next ? nxt.a + offA : cA; const bf16_t* nB = has_next ? nxt.b + offB : cB;
    for (int t = 0; t < nt; t += 2) {
      const bool last = (t == nt - 2);
      const bf16_t* a1 = cA + (size_t)(t + 1) * 64;
      const bf16_t* a2 = last ? nA : cA + (size_t)(t + 2) * 64; const bf16_t* b2 = last ? nB : cB + (size_t)(t + 2) * 64;
      const bf16_t* a3 = a2 + 64; const bf16_t* b3 = b2 + 64;
      G_LDB(B0, 0, 0); G_LDB(B1, 0, 1); SCHED; G_LDA(At, 0, 0); G_STAGE(G_SA(1, 1), a1 + ah, a64);
      WAIT_V(8); WAIT_L(0); BAR; G_MMA(0, 0, At, B0); G_MMA(0, 1, At, B1); BAR; SCHED;
      G_LDA(At, 0, 1); G_STAGE(G_SB(0, 0), b2, b64); G_STAGE(G_SB(0, 1), b2 + bh, b64); G_STAGE(G_SA(0, 0), a2, a64);
      WAIT_V(8); WAIT_L(0); BAR; G_MMA(1, 0, At, B0); G_MMA(1, 1, At, B1); BAR; SCHED;
      G_LDB(B0, 1, 0); G_LDB(B1, 1, 1); SCHED; G_LDA(At, 1, 0); G_STAGE(G_SA(0, 1), a2 + ah, a64);
      WAIT_V(8); WAIT_L(0); BAR; G_MMA(0, 0, At, B0); G_MMA(0, 1, At, B1); BAR; SCHED;
      G_LDA(At, 1, 1); G_STAGE(G_SB(1, 0), b3, b64); G_STAGE(G_SB(1, 1), b3 + bh, b64); G_STAGE(G_SA(1, 0), a3, a64);
      WAIT_V(8); WAIT_L(0); BAR; G_MMA(1, 0, At, B0); G_MMA(1, 1, At, B1); BAR; SCHED;
    }
    if (wr == 0) BAR;
    epi(acc, cur.brow, cur.bcol, cur.aux, wr, wc, fr, fq);
    if (!has_next) break;
#pragma unroll
    for (int a = 0; a < 2; ++a)
#pragma unroll
      for (int b = 0; b < 2; ++b)
#pragma unroll
        for (int m = 0; m < 4; ++m)
#pragma unroll
          for (int n = 0; n < 2; ++n) acc[a][b][m][n] = (f32x4){0.f, 0.f, 0.f, 0.f};
    cur = nxt; cA = nA; cB = nB; ++ui;
    if (wr == 1) BAR;
  }
  WAIT_V(0);
  BAR;
}

#define EPI_ROWS _Pragma("unroll") for (int ai = 0; ai < 2; ++ai) _Pragma("unroll") for (int m = 0; m < 4; ++m)
DI float row_rs(const float* ps, int row) {
  const f32x4* q = (const f32x4*)(ps + (size_t)row * 16); const f32x4 a = q[0], b = q[1], c = q[2], d = q[3];
  const float s = ((a[0] + a[1]) + (a[2] + a[3])) + ((b[0] + b[1]) + (b[2] + b[3])) + ((c[0] + c[1]) + (c[2] + c[3])) + ((d[0] + d[1]) + (d[2] + d[3]));
  return 1.0f / sqrtf(s * (1.f / DM) + 1e-6f);
}
DI float row_rs_shared(const float* ps, int row, int fr, int fq) { float rs = 0.f; if (fq == 0) rs = row_rs(ps, row); return __shfl(rs, fr); }
template <bool NORM> struct EpiGU {
  bf16_t* act; const float* ps; const float* shw;
  DI void operator()(EPI_ARGS) const {
    const int oc0 = (bcol >> 1) + wc * 32 + fq * 8;
    f32x4 sg0, sg1, su0, su1;
    if (NORM) { const float* sp = shw + (size_t)(brow >> 11) * 5632 + bcol + wc * 32 + fq * 8; sg0 = *(const f32x4*)sp; sg1 = *(const f32x4*)(sp + 4); su0 = *(const f32x4*)(sp + 128); su1 = *(const f32x4*)(sp + 132); }
    EPI_ROWS { const int row = brow + ai * 128 + wr * 64 + m * 16 + fr;
      f32x4 g0 = acc[ai][0][m][0], g1 = acc[ai][0][m][1], u0 = acc[ai][1][m][0], u1 = acc[ai][1][m][1];
      if (NORM) { const float rs = row_rs_shared(ps, row, fr, fq); g0 = g0 * rs + sg0; g1 = g1 * rs + sg1; u0 = u0 * rs + su0; u1 = u1 * rs + su1; }
      u32x4 w; w.x = pk2(silu_(g0[0]) * u0[0], silu_(g0[1]) * u0[1]); w.y = pk2(silu_(g0[2]) * u0[2], silu_(g0[3]) * u0[3]);
      w.z = pk2(silu_(g1[0]) * u1[0], silu_(g1[1]) * u1[1]); w.w = pk2(silu_(g1[2]) * u1[2], silu_(g1[3]) * u1[3]);
      *(u32x4*)(act + (size_t)row * FF + oc0) = w; }
  }
};
struct EpiRes {
  const float* Hin; float* Hout; const float* gate; float coef;
  DI void operator()(EPI_ARGS) const {
    EPI_ROWS { const int row = brow + ai * 128 + wr * 64 + m * 16 + fr; const int b = row >> 11;
#pragma unroll
      for (int bj = 0; bj < 2; ++bj)
#pragma unroll
        for (int n = 0; n < 2; ++n) { const int col = bcol + bj * 128 + wc * 32 + fq * 8 + n * 4;
          const f32x4 hin = *(const f32x4*)(Hin + (size_t)row * DM + col); const f32x4 g4 = *(const f32x4*)(gate + b * MODW + col);
          *(f32x4*)(Hout + (size_t)row * DM + col) = hin + coef * g4 * acc[ai][bj][m][n]; } }
  }
};
template <bool HIN_BF16, bool WRITE_H, int COEF2> struct EpiResN {
  const void* Hin; bf16_t* Hout; const float* gate; const float* gtab; bf16_t* Un; float* ps;
  DI void operator()(EPI_ARGS) const {
    constexpr float coef = 0.5f * COEF2;
    const int b = brow >> 11;
    f32x4 ssA = {0.f, 0.f, 0.f, 0.f}, ssB = {0.f, 0.f, 0.f, 0.f};
#pragma unroll
    for (int bj = 0; bj < 2; ++bj) { const int col = bcol + bj * 128 + wc * 32 + fq * 8;
      const f32x4 g0 = coef * *(const f32x4*)(gate + b * MODW + col), g1 = coef * *(const f32x4*)(gate + b * MODW + col + 4);
      const f32x4 t0 = *(const f32x4*)(gtab + b * DM + col), t1 = *(const f32x4*)(gtab + b * DM + col + 4);
      EPI_ROWS { const size_t off = (size_t)(brow + ai * 128 + wr * 64 + m * 16 + fr) * DM + col;
        f32x4 x0, x1;
        if (HIN_BF16) { const u32x4 hw = *(const u32x4*)((const bf16_t*)Hin + off);
          x0[0] = bflo(hw.x); x0[1] = bfhi(hw.x); x0[2] = bflo(hw.y); x0[3] = bfhi(hw.y); x1[0] = bflo(hw.z); x1[1] = bfhi(hw.z); x1[2] = bflo(hw.w); x1[3] = bfhi(hw.w); }
        else { x0 = *(const f32x4*)((const float*)Hin + off); x1 = *(const f32x4*)((const float*)Hin + off + 4); }
        const f32x4 h0 = x0 + g0 * acc[ai][bj][m][0], h1 = x1 + g1 * acc[ai][bj][m][1];
        if (WRITE_H) { u32x4 hv; hv.x = pk2(h0[0], h0[1]); hv.y = pk2(h0[2], h0[3]); hv.z = pk2(h1[0], h1[1]); hv.w = pk2(h1[2], h1[3]); *(u32x4*)(Hout + off) = hv; }
        const f32x4 a0 = h0 * t0, a1 = h1 * t1;
        u32x4 w; w.x = pk2(a0[0], a0[1]); w.y = pk2(a0[2], a0[3]); w.z = pk2(a1[0], a1[1]); w.w = pk2(a1[2], a1[3]);
        *(u32x4*)(Un + off) = w;
        const float sq = ((h0[0] * h0[0] + h0[1] * h0[1]) + (h0[2] * h0[2] + h0[3] * h0[3])) + ((h1[0] * h1[0] + h1[1] * h1[1]) + (h1[2] * h1[2] + h1[3] * h1[3]));
        if (ai == 0) ssA[m] += sq; else ssB[m] += sq; } }
    EPI_ROWS { float s = ai == 0 ? ssA[m] : ssB[m]; s += __shfl_xor(s, 16); s += __shfl_xor(s, 32);
      if (fq == 0) ps[(size_t)(brow + ai * 128 + wr * 64 + m * 16 + fr) * 16 + (bcol >> 8) * 4 + wc] = s; }
  }
};
struct EpiShW {
  float* out; int ldo;
  DI void operator()(EPI_ARGS) const {
    if (wr == 0) {
#pragma unroll
      for (int bj = 0; bj < 2; ++bj) { float* o = out + (size_t)fr * ldo + bcol + bj * 128 + wc * 32 + fq * 8;
        *(f32x4*)o = acc[0][bj][0][0]; *(f32x4*)(o + 4) = acc[0][bj][0][1]; }
    }
  }
};
struct OneUnit { const bf16_t* a; const bf16_t* b; int bcol;
  DI bool next(int i, UnitD& d) const { if (i > 0) return false; d.brow = 0; d.bcol = bcol; d.aux = 0; d.a = a; d.b = b; return true; } };
struct EpiProj {
  bf16_t* proj; bf16_t* kvc; const float* ps; const float* shw;
  DI void operator()(EPI_ARGS) const {
    f32x4 sw[2][2];
    { const float* sp = shw + (size_t)(brow >> 11) * LDP + bcol + wc * 32 + fq * 8; sw[0][0] = *(const f32x4*)sp; sw[0][1] = *(const f32x4*)(sp + 4); sw[1][0] = *(const f32x4*)(sp + 128); sw[1][1] = *(const f32x4*)(sp + 132); }
    EPI_ROWS { const int row = brow + ai * 128 + wr * 64 + m * 16 + fr; const float rs = row_rs_shared(ps, row, fr, fq);
#pragma unroll
      for (int bj = 0; bj < 2; ++bj) { const int col = bcol + bj * 128 + wc * 32 + fq * 8; const f32x4 v0 = acc[ai][bj][m][0] * rs + sw[bj][0], v1 = acc[ai][bj][m][1] * rs + sw[bj][1];
        u32x4 w; w.x = pk2(v0[0], v0[1]); w.y = pk2(v0[2], v0[3]); w.z = pk2(v1[0], v1[1]); w.w = pk2(v1[2], v1[3]);
        *(u32x4*)(proj + (size_t)row * LDP + col) = w;
        if (bcol == 512) { const int c = col - 512, kv = c >> 7, g = (c >> 6) & 1, d = c & 63, b = row >> 11, s = row & 2047;
          *(u32x4*)(kvc + ((((size_t)kv * NB + b) * 2 + g) * SEQ + s) * 64 + d) = w; } } }
  }
};
struct EpiHid {
  bf16_t* hid; const float* bias;
  DI void operator()(EPI_ARGS) const {
    EPI_ROWS { const int row = brow + ai * 128 + wr * 64 + m * 16 + fr;
#pragma unroll
      for (int bj = 0; bj < 2; ++bj) { const int col = bcol + bj * 128 + wc * 32 + fq * 8;
        const f32x4 v0 = acc[ai][bj][m][0] + *(const f32x4*)(bias + col), v1 = acc[ai][bj][m][1] + *(const f32x4*)(bias + col + 4);
        u32x4 w; w.x = pk2(gelu_tanh(v0[0]), gelu_tanh(v0[1])); w.y = pk2(gelu_tanh(v0[2]), gelu_tanh(v0[3])); w.z = pk2(gelu_tanh(v1[0]), gelu_tanh(v1[1])); w.w = pk2(gelu_tanh(v1[2]), gelu_tanh(v1[3]));
        *(u32x4*)(hid + (size_t)row * 256 + col) = w; } }
  }
};
struct EpiUp {
  bf16_t* proj; bf16_t* merged;
  DI void operator()(EPI_ARGS) const {
    EPI_ROWS { const int row = brow + ai * 128 + wr * 64 + m * 16 + fr; bf16_t* pr = proj + (size_t)row * LDP;
#pragma unroll
      for (int bj = 0; bj < 2; ++bj) { const int col = bcol + bj * 128 + wc * 32 + fq * 8; const f32x4 v0 = acc[ai][bj][m][0], v1 = acc[ai][bj][m][1];
        const u32x4 gw = *(const u32x4*)(pr + 2048 + aux * 1024 + col);
        f32x4 o0, o1; o0[0] = sigm(bflo(gw.x)) * v0[0]; o0[1] = sigm(bfhi(gw.x)) * v0[1]; o0[2] = sigm(bflo(gw.y)) * v0[2]; o0[3] = sigm(bfhi(gw.y)) * v0[3];
        o1[0] = sigm(bflo(gw.z)) * v1[0]; o1[1] = sigm(bfhi(gw.z)) * v1[1]; o1[2] = sigm(bflo(gw.w)) * v1[2]; o1[3] = sigm(bfhi(gw.w)) * v1[3];
        bf16_t* tp = pr + col;
        if (aux == 0) { u32x4 w; w.x = pk2(o0[0], o0[1]); w.y = pk2(o0[2], o0[3]); w.z = pk2(o1[0], o1[1]); w.w = pk2(o1[2], o1[3]); *(u32x4*)tp = w; }
        else { const u32x4 tw = *(const u32x4*)tp;
          f32x4 t0, t1; t0[0] = bflo(tw.x) + o0[0]; t0[1] = bfhi(tw.x) + o0[1]; t0[2] = bflo(tw.y) + o0[2]; t0[3] = bfhi(tw.y) + o0[3];
          t1[0] = bflo(tw.z) + o1[0]; t1[1] = bfhi(tw.z) + o1[1]; t1[2] = bflo(tw.w) + o1[2]; t1[3] = bfhi(tw.w) + o1[3];
          u32x4 w; w.x = pk2(t0[0], t0[1]); w.y = pk2(t0[2], t0[3]); w.z = pk2(t1[0], t1[1]); w.w = pk2(t1[2], t1[3]);
          *(u32x4*)(merged + (size_t)row * DM + col) = w; } } }
  }
};
struct UpUnits { const bf16_t* ya; const bf16_t* yb; const bf16_t* wa; const bf16_t* wb;
  DI bool next(int i, UnitD& d) const { int pm, pn; if (!unit_of((i >> 1) * (int)gridDim.x + (int)blockIdx.x, 128, 4, pm, pn)) return false;
    d.brow = pm * 256; d.bcol = pn * 256; d.aux = i & 1; d.a = ((i & 1) ? yb : ya) + (size_t)d.brow * 512; d.b = ((i & 1) ? wb : wa) + (size_t)d.bcol * 512; return true; } };
struct CmpUnits { const bf16_t* kvc; const bf16_t* w1t;
  DI bool next(int i, UnitD& d) const { if (i > 0 || blockIdx.x >= 32) return false; const int kv = blockIdx.x >> 4, pm = blockIdx.x & 15;
    d.brow = pm * 256; d.bcol = 0; d.aux = kv; d.a = kvc + (size_t)kv * SZ_KVC1 + (size_t)d.brow * 1024; d.b = w1t + (size_t)kv * 256 * 2048; return true; } };
struct EpiHid2 { bf16_t* hid; const float* cb;
  DI void operator()(EPI_ARGS) const { EpiHid{hid + (size_t)aux * 4096 * 256, cb + aux * 256}(acc, brow, bcol, aux, wr, wc, fr, fq); } };

constexpr int VST = 192;
constexpr int AL_SLOT = 9216 + 64 * VST;
constexpr int AL_IA = 2 * AL_SLOT, AL_IB = AL_IA + 4 * 64 * 33 * 4, AL_SEL = AL_IB + 4 * 64 * 33 * 4, AL_UNI = AL_SEL + 256;
#define MFMA32(a, b, c) __builtin_amdgcn_mfma_f32_32x32x16_bf16((a), (b), (c), 0, 0, 0)

struct TileP { int j; int lim_hi, lim_lo; float rowbias; };

DI void tile_scores(const int slot, const bf16x8 (&qf)[4], f32x16& s0, f32x16& s1, LAS unsigned char* lds) {
  const int lane = otid() & 63, r = lane & 31, h = lane >> 5;
#pragma unroll
  for (int i = 0; i < 16; ++i) { s0[i] = 0.f; s1[i] = 0.f; }
  LAS unsigned char* kl = lds + slot * AL_SLOT + r * 144 + h * 16;
#pragma unroll
  for (int ks = 0; ks < 4; ++ks) {
    const bf16x8 k0 = *(const LAS bf16x8*)(kl + ks * 32);
    const bf16x8 k1 = *(const LAS bf16x8*)(kl + 32 * 144 + ks * 32);
    s0 = MFMA32(k0, qf[ks], s0);
    s1 = MFMA32(k1, qf[ks], s1);
  }
}
template <int MODE, bool MASKED>
DI void tile_softmax(const TileP& tp, f32x16& s0, f32x16& s1, const float slope2, const int t, f32x16 (&o)[2], float& m, float& l, float (&G)[8], float (&Lr)[8]) {
  const int lane = threadIdx.x & 63, h = lane >> 5;
  float base, cstep;
  if (MODE == 0) { base = slope2 * (float)(16 * (tp.j * 64 + 4 * h) + 31 - t); cstep = 16.f * slope2; }
  else { base = slope2 * (float)(tp.j * 64 + 4 * h - t) + tp.rowbias; cstep = slope2; }
  float tm = -1e30f;
#pragma unroll
  for (int i = 0; i < 16; ++i) {
    const int c0 = 8 * (i >> 2) + (i & 3), c1 = 32 + c0;
    float v0 = __builtin_fmaf(s0[i], C1, __builtin_fmaf(cstep, (float)c0, base));
    float v1 = __builtin_fmaf(s1[i], C1, __builtin_fmaf(cstep, (float)c1, base));
    if (MASKED) { v0 = (c0 <= tp.lim_hi && c0 >= tp.lim_lo) ? v0 : -1e30f; v1 = (c1 <= tp.lim_hi && c1 >= tp.lim_lo) ? v1 : -1e30f; }
    s0[i] = v0; s1[i] = v1; tm = fmaxf(tm, fmaxf(v0, v1));
  }
  tm = fmaxf(tm, __shfl_xor(tm, 32));
  const float mn = fmaxf(m, tm), alpha = fexp2(m - mn); m = mn;
  float ls = 0.f;
#pragma unroll
  for (int i = 0; i < 16; ++i) { const float p0 = fexp2(s0[i] - mn), p1 = fexp2(s1[i] - mn); s0[i] = p0; s1[i] = p1; ls += p0 + p1; }
  l = l * alpha + ls;
#pragma unroll
  for (int i = 0; i < 16; ++i) { o[0][i] *= alpha; o[1][i] *= alpha; }
  if (MODE == 0) {
#pragma unroll
    for (int g4 = 0; g4 < 4; ++g4) {
      G[g4] = (s0[4 * g4] + s0[4 * g4 + 1]) + (s0[4 * g4 + 2] + s0[4 * g4 + 3]); Lr[g4] = s0[4 * g4 + 3];
      G[4 + g4] = (s1[4 * g4] + s1[4 * g4 + 1]) + (s1[4 * g4 + 2] + s1[4 * g4 + 3]); Lr[4 + g4] = s1[4 * g4 + 3];
    }
  }
}
DI void tile_pv(const int slot, const f32x16& s0, const f32x16& s1, f32x16 (&o)[2], LAS unsigned char* lds) {
  const int lane = otid() & 63, h = lane >> 5;
  const int i16 = lane & 15, q4 = i16 >> 2, p4 = i16 & 3, blk = (lane >> 4) & 1;
  LAS unsigned char* vl = lds + slot * AL_SLOT + 9216 + (4 * h + q4) * VST + blk * 32 + 8 * p4;
#pragma unroll
  for (int kb = 0; kb < 2; ++kb)
#pragma unroll
    for (int sp = 0; sp < 2; ++sp) {
      u32x4 pw;
      if (kb == 0) { pw.x = pk2(s0[8 * sp], s0[8 * sp + 1]); pw.y = pk2(s0[8 * sp + 2], s0[8 * sp + 3]); pw.z = pk2(s0[8 * sp + 4], s0[8 * sp + 5]); pw.w = pk2(s0[8 * sp + 6], s0[8 * sp + 7]); }
      else { pw.x = pk2(s1[8 * sp], s1[8 * sp + 1]); pw.y = pk2(s1[8 * sp + 2], s1[8 * sp + 3]); pw.z = pk2(s1[8 * sp + 4], s1[8 * sp + 5]); pw.w = pk2(s1[8 * sp + 6], s1[8 * sp + 7]); }
      const bf16x8 pf = __builtin_bit_cast(bf16x8, pw);
      LAS unsigned char* vb = vl + (kb * 32 + 16 * sp) * VST;
#pragma unroll
      for (int db = 0; db < 2; ++db) {
        const s16x4 lo = __builtin_amdgcn_ds_read_tr16_b64_v4i16((LAS s16x4*)(vb + db * 64));
        const s16x4 hi = __builtin_amdgcn_ds_read_tr16_b64_v4i16((LAS s16x4*)(vb + db * 64 + 8 * VST));
        const bf16x8 vf = __builtin_shufflevector(lo, hi, 0, 1, 2, 3, 4, 5, 6, 7);
        o[db] = MFMA32(vf, pf, o[db]);
      }
    }
}
template <int MODE, bool MA, bool MB>
DI void pair_compute(const TileP& ta, const TileP& tb, const bf16x8 (&qf)[4], const float slope2, const int t, f32x16 (&o)[2], float& m, float& l,
                     float (&GA)[8], float (&LA)[8], float (&GB)[8], float (&LB)[8], float& m_after_a, LAS unsigned char* lds) {
  const bool early = (MODE != 0) && ((threadIdx.x >> 8) & 1) != 0;
  f32x16 a0, a1, b0, b1;
  tile_scores(0, qf, a0, a1, lds);
  if (early) tile_scores(1, qf, b0, b1, lds);
  __builtin_amdgcn_sched_barrier(0);
  tile_softmax<MODE, MA>(ta, a0, a1, slope2, t, o, m, l, GA, LA);
  m_after_a = m;
  __builtin_amdgcn_sched_barrier(0);
  tile_pv(0, a0, a1, o, lds);
  __builtin_amdgcn_sched_barrier(0);
  if (!early) tile_scores(1, qf, b0, b1, lds);
  __builtin_amdgcn_sched_barrier(0);
  tile_softmax<MODE, MB>(tb, b0, b1, slope2, t, o, m, l, GB, LB);
  __builtin_amdgcn_sched_barrier(0);
  tile_pv(1, b0, b1, o, lds);
}
template <int MODE, bool MA>
DI void single_compute(const TileP& ta, const bf16x8 (&qf)[4], const float slope2, const int t, f32x16 (&o)[2], float& m, float& l, LAS unsigned char* lds) {
  f32x16 a0, a1; float Gd[8], Ld[8];
  tile_scores(0, qf, a0, a1, lds);
  tile_softmax<MODE, MA>(ta, a0, a1, slope2, t, o, m, l, Gd, Ld);
  tile_pv(0, a0, a1, o, lds);
}
struct StageRegs { u32x4 k0, v0, k1, v1; };
DI void stage_load(StageRegs& sr, const bf16_t* Kp, const bf16_t* Vp, const int stride, const int ja, const int jb) {
  const int tid = otid(), srow = tid >> 3, sch = tid & 7;
  sr.k0 = *(const u32x4*)(Kp + (size_t)(ja * 64 + srow) * stride + sch * 8);
  sr.v0 = *(const u32x4*)(Vp + (size_t)(ja * 64 + srow) * stride + sch * 8);
  sr.k1 = *(const u32x4*)(Kp + (size_t)(jb * 64 + srow) * stride + sch * 8);
  sr.v1 = *(const u32x4*)(Vp + (size_t)(jb * 64 + srow) * stride + sch * 8);
}
DI void stage_store(const StageRegs& sr, LAS unsigned char* lds) {
  const int tid = otid(), srow = tid >> 3, sch = tid & 7;
  LAS unsigned char* d = lds + srow * 144 + sch * 16; LAS unsigned char* dv = lds + 9216 + srow * VST + sch * 16;
  *(LAS u32x4*)(d) = sr.k0; *(LAS u32x4*)(dv) = sr.v0; *(LAS u32x4*)(d + AL_SLOT) = sr.k1; *(LAS u32x4*)(dv + AL_SLOT) = sr.v1;
}

template <int MODE>
DI void attn_branch(unsigned tilemask, const bf16_t* Kp, const bf16_t* Vp, const int stride, const bf16x8 (&qf)[4], const float slope2, const int t, const int cur,
                    const unsigned mysel, f32x16 (&o)[2], float& m, float& l, LAS unsigned char* lds) {
  const int lane = threadIdx.x & 63, h = lane >> 5;
  float GA[8], LA[8], GB[8], LB[8], mdum;
  StageRegs sr;
  { const int ja = __builtin_ctz(tilemask); const unsigned rest = tilemask & (tilemask - 1); const int jb = rest ? __builtin_ctz(rest) : ja;
    stage_load(sr, Kp, Vp, stride, ja, jb); }
  while (tilemask) {
    const int ja = __builtin_ctz(tilemask); tilemask &= tilemask - 1;
    const bool hasb = tilemask != 0; const int jb = hasb ? __builtin_ctz(tilemask) : ja; if (hasb) tilemask &= tilemask - 1;
    __syncthreads();
    stage_store(sr, lds);
    __syncthreads();
    if (tilemask) { const int na = __builtin_ctz(tilemask); const unsigned rest = tilemask & (tilemask - 1); const int nb = rest ? __builtin_ctz(rest) : na;
      stage_load(sr, Kp, Vp, stride, na, nb); }
    TileP ta, tb; bool ma = false, mb = false;
    { const int rel = t - ja * 64 - 4 * h; ta.j = ja; ta.lim_hi = 1000; ta.lim_lo = -100000; ta.rowbias = 0.f;
      if (ja == cur) { ta.lim_hi = rel; ma = true; }
      if (MODE == 1 && !((mysel >> ja) & 1u)) ta.rowbias = -1e30f;
      if (MODE == 2 && ja == cur - 8) { ta.lim_lo = rel - 511; ma = true; }
      if (MODE == 3 && ja == cur - 2) { ta.lim_lo = rel - 127; ma = true; } }
    { const int rel = t - jb * 64 - 4 * h; tb.j = jb; tb.lim_hi = 1000; tb.lim_lo = -100000; tb.rowbias = 0.f;
      if (jb == cur) { tb.lim_hi = rel; mb = true; }
      if (MODE == 1 && !((mysel >> jb) & 1u)) tb.rowbias = -1e30f;
      if (MODE == 2 && jb == cur - 8) { tb.lim_lo = rel - 511; mb = true; }
      if (MODE == 3 && jb == cur - 2) { tb.lim_lo = rel - 127; mb = true; } }
    if (hasb) {
      if (ma) { if (mb) pair_compute<MODE, true, true>(ta, tb, qf, slope2, t, o, m, l, GA, LA, GB, LB, mdum, lds);
                else pair_compute<MODE, true, false>(ta, tb, qf, slope2, t, o, m, l, GA, LA, GB, LB, mdum, lds); }
      else { if (mb) pair_compute<MODE, false, true>(ta, tb, qf, slope2, t, o, m, l, GA, LA, GB, LB, mdum, lds);
             else pair_compute<MODE, false, false>(ta, tb, qf, slope2, t, o, m, l, GA, LA, GB, LB, mdum, lds); }
    } else {
      if (ma) single_compute<MODE, true>(ta, qf, slope2, t, o, m, l, lds);
      else single_compute<MODE, false>(ta, qf, slope2, t, o, m, l, lds);
    }
  }
}

DI void zero_o(f32x16 (&o)[2]) {
#pragma unroll
  for (int i = 0; i < 16; ++i) { o[0][i] = 0.f; o[1][i] = 0.f; }
}
template <int STEP>
DI void y_step(f32x16 (&o)[2], const float sc, LAS unsigned char* lds) {
  const int tid = threadIdx.x, wid = tid >> 6, lane = tid & 63;
  LAS f32x4* yb = (LAS f32x4*)(lds + AL_IA) + (wid * 8) * 64 + lane;
#pragma unroll
  for (int db = 0; db < 2; ++db)
#pragma unroll
    for (int g4 = 0; g4 < 4; ++g4) {
      f32x4 v = {sc * o[db][4 * g4], sc * o[db][4 * g4 + 1], sc * o[db][4 * g4 + 2], sc * o[db][4 * g4 + 3]};
      LAS f32x4* s = yb + (db * 4 + g4) * 64;
      if (STEP >= 1) v = v + *s;
      if (STEP <= 1) *s = v;
      else { o[db][4 * g4] = v[0]; o[db][4 * g4 + 1] = v[1]; o[db][4 * g4 + 2] = v[2]; o[db][4 * g4 + 3] = v[3]; }
    }
}
DI void store_y(bf16_t* yrow, const f32x16 (&y)[2], int h) {
#pragma unroll
  for (int db = 0; db < 2; ++db)
#pragma unroll
    for (int g4 = 0; g4 < 4; ++g4) { u32x2 w; w.x = pk2(y[db][4 * g4], y[db][4 * g4 + 1]); w.y = pk2(y[db][4 * g4 + 2], y[db][4 * g4 + 3]);
      *(u32x2*)(yrow + db * 32 + 8 * g4 + 4 * h) = w; }
}

DI void swa_unit(const Params& p, int unit, LAS unsigned char* lds) {
  const int qt = unit & 31, g = (unit >> 5) & 1, b = unit >> 6;
  const int tid = threadIdx.x, wid = tid >> 6, lane = tid & 63, r = lane & 31, h = lane >> 5;
  const int hh = g * 4 + (wid >> 1), t = qt * 64 + (wid & 1) * 32 + r; const size_t row = (size_t)b * SEQ + t;
  const bf16_t* proj = (const bf16_t*)(p.ws + OFF_ACT);
  const float slope2 = fexp2(-(float)(hh + 1)) * LOG2E;
  bf16x8 qf[4];
  { const bf16_t* qp = proj + row * LDP + 1280 + hh * 64 + h * 8;
#pragma unroll
    for (int ks = 0; ks < 4; ++ks) qf[ks] = *(const bf16x8*)(qp + ks * 16); }
  f32x16 o[2]; zero_o(o); float m = -1e4f, l = 0.f;
  const int jlo = qt >= 2 ? qt - 2 : 0;
  const unsigned tmask = ((2u << qt) - 1u) & ~((1u << jlo) - 1u);
  const bf16_t* kvb = proj + (size_t)b * SEQ * LDP;
  attn_branch<3>(tmask, kvb + 1792 + g * 64, kvb + 1920 + g * 64, LDP, qf, slope2, t, qt, 0u, o, m, l, lds);
  float lt = l + __shfl_xor(l, 32);
  lt += fexp2(p.in[16][hh] * LOG2E - m);
  const float inv = frcp(lt);
#pragma unroll
  for (int i = 0; i < 16; ++i) { o[0][i] *= inv; o[1][i] *= inv; }
  store_y((bf16_t*)(p.ws + OFF_YB) + row * 512 + hh * 64, o, h);
  __syncthreads();
}

DI void nsa_unit(const Params& p, int unit, LAS unsigned char* lds) {
  const int qt = unit & 31, g = (unit >> 5) & 1, b = unit >> 6;
  const int tid = threadIdx.x, wid = tid >> 6, lane = tid & 63, r = lane & 31, h = lane >> 5;
  const int hr = wid >> 1, qloc = (wid & 1) * 32 + r, hh = g * 4 + hr, t = qt * 64 + qloc; const size_t row = (size_t)b * SEQ + t;
  const bf16_t* proj = (const bf16_t*)(p.ws + OFF_ACT);
  const float slope2 = fexp2(-(float)(hh + 1)) * LOG2E;
  bf16x8 qf[4];
  { const bf16_t* qp = proj + row * LDP + hh * 64 + h * 8;
#pragma unroll
    for (int ks = 0; ks < 4; ++ks) qf[ks] = *(const bf16x8*)(qp + ks * 16); }
  float gt0, gt1, gt2;
  { const bf16_t* gp = proj + row * LDP + 4096 + hh * 3; gt0 = sigm(bf2f(gp[0])); gt1 = sigm(bf2f(gp[1])); gt2 = sigm(bf2f(gp[2])); }
  if (tid == 0) *(LAS unsigned*)(lds + AL_UNI) = 0u;
  f32x16 o[2];
  float sc_cmp;
  {
    zero_o(o); float m = -1e4f, l = 0.f;
    const bf16_t* kc = (const bf16_t*)(p.ws + OFF_KC) + (size_t)(b * 2 + g) * 128 * 64;
    const bf16_t* vc = kc + (size_t)4096 * 64;
    const int nmax = t >= 31 ? ((t - 31) >> 4) : -1;
    float G0[8], L0[8], G1[8], L1[8], m0;
    StageRegs sr; stage_load(sr, kc, vc, 64, 0, 1);
    __syncthreads();
    stage_store(sr, lds);
    __syncthreads();
    TileP ta, tb; ta.j = 0; ta.lim_hi = nmax - 4 * h; ta.lim_lo = -100000; ta.rowbias = 0.f; tb.j = 1; tb.lim_hi = nmax - 64 - 4 * h; tb.lim_lo = -100000; tb.rowbias = 0.f;
    pair_compute<0, true, true>(ta, tb, qf, slope2, t, o, m, l, G0, L0, G1, L1, m0, lds);
    const float lt = l + __shfl_xor(l, 32);
    const float inv = lt > 0.f ? frcp(lt) : 0.f;
    const float f0 = fexp2(m0 - m) * inv, f1 = inv;
    LAS float* ia = (LAS float*)(lds + AL_IA) + (hr * 64 + qloc) * 33;
    LAS float* ib = (LAS float*)(lds + AL_IB) + (hr * 64 + qloc) * 33;
#pragma unroll
    for (int kb = 0; kb < 2; ++kb)
#pragma unroll
      for (int g4 = 0; g4 < 4; ++g4) {
        const int j0 = kb * 8 + 2 * g4 + h, j1 = 16 + j0;
        ia[j0] = G0[kb * 4 + g4] * f0; ib[j0 + 1] = L0[kb * 4 + g4] * f0;
        ia[j1] = G1[kb * 4 + g4] * f1; if (j1 < 31) ib[j1 + 1] = L1[kb * 4 + g4] * f1;
      }
    sc_cmp = gt0 * inv;
  }
  __syncthreads();
  {
    const int cur = qt, q = tid >> 3, part = tid & 7; unsigned mask;
    if (cur <= 7) mask = (2u << cur) - 1u;
    else {
      LAS float* ia = (LAS float*)(lds + AL_IA) + q * 33;
      LAS float* ib = (LAS float*)(lds + AL_IB) + q * 33;
      float v[4];
#pragma unroll
      for (int i = 0; i < 4; ++i) { const int j = part + 8 * i; float s = -2.f;
        if (j >= 1 && j <= cur - 2) { s = 0.f;
#pragma unroll
          for (int hd = 0; hd < 4; ++hd) s += ia[hd * 64 * 33 + j] + ib[hd * 64 * 33 + j]; }
        v[i] = s; }
      mask = 1u | (1u << cur) | (1u << (cur - 1));
#pragma unroll
      for (int k = 0; k < 5; ++k) {
        float best = v[0]; int bi = part;
#pragma unroll
        for (int i = 1; i < 4; ++i) if (v[i] > best) { best = v[i]; bi = part + 8 * i; }
#pragma unroll
        for (int sh = 1; sh < 8; sh <<= 1) { const float ob = __shfl_xor(best, sh); const int oi = __shfl_xor(bi, sh);
          if (ob > best || (ob == best && oi < bi)) { best = ob; bi = oi; } }
        mask |= 1u << bi;
#pragma unroll
        for (int i = 0; i < 4; ++i) if (bi == part + 8 * i) v[i] = -2.f;
      }
    }
    if (part == 0) { *((LAS unsigned*)(lds + AL_SEL) + q) = mask; atomicOr((unsigned*)(LAS unsigned*)(lds + AL_UNI), mask); }
  }
  __syncthreads();
  const unsigned mysel = *((LAS unsigned*)(lds + AL_SEL) + qloc);
  const unsigned uni = *(LAS unsigned*)(lds + AL_UNI);
  const bf16_t* kvb = proj + (size_t)b * SEQ * LDP;
  __syncthreads();
  y_step<0>(o, sc_cmp, lds);
  {
    zero_o(o); float m = -1e4f, l = 0.f;
    attn_branch<1>(uni & ((2u << qt) - 1u), kvb + 768 + g * 64, kvb + 896 + g * 64, LDP, qf, slope2, t, qt, mysel, o, m, l, lds);
    const float lt = l + __shfl_xor(l, 32); const float sc = gt1 * (lt > 0.f ? frcp(lt) : 0.f);
    y_step<1>(o, sc, lds);
  }
  {
    zero_o(o); float m = -1e4f, l = 0.f;
    const int jlo = qt >= 8 ? qt - 8 : 0;
    attn_branch<2>(((2u << qt) - 1u) & ~((1u << jlo) - 1u), kvb + 1024 + g * 64, kvb + 1152 + g * 64, LDP, qf, slope2, t, qt, 0u, o, m, l, lds);
    const float lt = l + __shfl_xor(l, 32); const float sc = gt2 * (lt > 0.f ? frcp(lt) : 0.f);
    y_step<2>(o, sc, lds);
  }
  store_y((bf16_t*)(p.ws + OFF_YA) + row * 512 + hh * 64, o, h);
  __syncthreads();
}

DI int rowmap(int n, int mode) {
  if (mode == 0) return n;
  if (mode == 1) return (n >> 7) * 256 + (n & 127);
  if (mode == 2) return (n >> 7) * 256 + 128 + (n & 127);
  return n < 1280 ? n : (n < 1304 ? 4096 + (n - 1280) : n - 24);
}
struct TrItem { const float* W; bf16_t* WT; int K, N, mode, k0, n0; };
constexpr int TR_LD = 261;
DI void tr_load(const TrItem& it, f32x4 (&v)[8]) {
  const int tid = otid(), c4 = (tid & 63) * 4, kr = tid >> 6;
#pragma unroll
  for (int i = 0; i < 8; ++i) { const int kk = kr + 8 * i;
    v[i] = (it.n0 + c4 < it.N) ? *(const f32x4*)(it.W + (size_t)(it.k0 + kk) * it.N + it.n0 + c4) : (f32x4){0.f, 0.f, 0.f, 0.f}; }
}
DI void tr_to_lds(const f32x4 (&v)[8], LAS unsigned char* lds) {
  const int tid = otid(), c4 = (tid & 63) * 4, kr = tid >> 6; LAS float* tile = (LAS float*)lds;
#pragma unroll
  for (int i = 0; i < 8; ++i) { LAS float* d = tile + (kr + 8 * i) * TR_LD + c4; d[0] = v[i][0]; d[1] = v[i][1]; d[2] = v[i][2]; d[3] = v[i][3]; }
}
DI void tr_store(const TrItem& it, LAS unsigned char* lds) {
  const int tid = otid(); LAS float* tile = (LAS float*)lds;
  const int ch = tid & 7;
#pragma unroll
  for (int i = 0; i < 4; ++i) { const int nn = (tid >> 3) + 64 * i; LAS float* s = tile + (ch * 8) * TR_LD + nn;
    u32x4 w; w.x = pk2(s[0], s[TR_LD]); w.y = pk2(s[2 * TR_LD], s[3 * TR_LD]); w.z = pk2(s[4 * TR_LD], s[5 * TR_LD]); w.w = pk2(s[6 * TR_LD], s[7 * TR_LD]);
    if (it.n0 + nn < it.N) *(u32x4*)(it.WT + (size_t)rowmap(it.n0 + nn, it.mode) * it.K + it.k0 + ch * 8) = w; }
}
DI void mod_item(const Params& p, int item, LAS unsigned char* lds) {
  const int tid = threadIdx.x, n0 = item * 64, kq = tid >> 6, nn = tid & 63;
  LAS float* sc = (LAS float*)lds;
  LAS float* red = (LAS float*)(lds + 65536);
  for (int e = tid; e < NB * DM; e += 512) sc[e] = silu_(p.in[1][e]);
  __syncthreads();
  float acc[16];
#pragma unroll
  for (int b = 0; b < 16; ++b) acc[b] = 0.f;
  const float* w = p.in[2] + (size_t)(kq * 128) * MODW + n0 + nn;
  for (int k = 0; k < 128; k += 4) { const float w0 = w[(size_t)k * MODW], w1 = w[(size_t)(k + 1) * MODW], w2 = w[(size_t)(k + 2) * MODW], w3 = w[(size_t)(k + 3) * MODW];
#pragma unroll
    for (int b = 0; b < 16; ++b) { const f32x4 s4 = *(const LAS f32x4*)(sc + b * DM + kq * 128 + k);
      acc[b] = __builtin_fmaf(s4[0], w0, acc[b]); acc[b] = __builtin_fmaf(s4[1], w1, acc[b]); acc[b] = __builtin_fmaf(s4[2], w2, acc[b]); acc[b] = __builtin_fmaf(s4[3], w3, acc[b]); } }
#pragma unroll
  for (int b = 0; b < 16; ++b) red[(kq * 16 + b) * 64 + nn] = acc[b];
  __syncthreads();
  float* mod = (float*)(p.ws + OFF_MOD);
  for (int e = tid; e < 1024; e += 512) { const int b = e >> 6, n = e & 63; float s = p.in[3][n0 + n];
#pragma unroll
    for (int q = 0; q < 8; ++q) s += red[(q * 16 + b) * 64 + n];
    mod[b * MODW + n0 + n] = s; }
  __syncthreads();
}
DI void phase0(const Params& p, LAS unsigned char* lds) {
  const int tid = otid(), bid = blockIdx.x, G = gridDim.x;
  for (int it = bid; it < 144; it += G) mod_item(p, it, lds);
  bf16_t* wgu1 = (bf16_t*)(p.ws + OFF_WGU1); bf16_t* wd1 = (bf16_t*)(p.ws + OFF_WD1); bf16_t* wgu2 = (bf16_t*)(p.ws + OFF_WGU2); bf16_t* wd2 = (bf16_t*)(p.ws + OFF_WD2);
  bf16_t* win = (bf16_t*)(p.ws + OFF_WIN); bf16_t* wupa = (bf16_t*)(p.ws + OFF_WUPA); bf16_t* wupb = (bf16_t*)(p.ws + OFF_WUPB); bf16_t* wout = (bf16_t*)(p.ws + OFF_WOUT);
  bf16_t* w1t = (bf16_t*)(p.ws + OFF_W1T);
  constexpr int I_G = 16 * 11, I_D = 44 * 4, I_IN = 16 * 17, I_UP = 8 * 4, I_OUT = 16 * 4, I_C = 32 * 1;
  constexpr int NIT = 4 * I_G + 2 * I_D + I_IN + 2 * I_UP + I_OUT + 2 * I_C;
  auto decode = [&](int it, TrItem& d) {
    int r = it; const float* W; bf16_t* WT; int K, N, mode;
    if (r < I_G) { W = p.in[5]; K = 1024; N = FF; WT = wgu1; mode = 1; }
    else if ((r -= I_G) < I_G) { W = p.in[6]; K = 1024; N = FF; WT = wgu1; mode = 2; }
    else if ((r -= I_G) < I_D) { W = p.in[7]; K = FF; N = 1024; WT = wd1; mode = 0; }
    else if ((r -= I_D) < I_G) { W = p.in[21]; K = 1024; N = FF; WT = wgu2; mode = 1; }
    else if ((r -= I_G) < I_G) { W = p.in[22]; K = 1024; N = FF; WT = wgu2; mode = 2; }
    else if ((r -= I_G) < I_D) { W = p.in[23]; K = FF; N = 1024; WT = wd2; mode = 0; }
    else if ((r -= I_D) < I_IN) { W = p.in[9]; K = 1024; N = INW; WT = win; mode = 3; }
    else if ((r -= I_IN) < I_UP) { W = p.in[17]; K = 512; N = 1024; WT = wupa; mode = 0; }
    else if ((r -= I_UP) < I_UP) { W = p.in[18]; K = 512; N = 1024; WT = wupb; mode = 0; }
    else if ((r -= I_UP) < I_OUT) { W = p.in[19]; K = 1024; N = 1024; WT = wout; mode = 0; }
    else if ((r -= I_OUT) < I_C) { W = p.in[11]; K = 2048; N = 256; WT = w1t; mode = 0; }
    else { r -= I_C; W = p.in[14]; K = 2048; N = 256; WT = w1t + (size_t)256 * 2048; mode = 0; }
    const int ntn = (N + 255) >> 8;
    d.W = W; d.WT = WT; d.K = K; d.N = N; d.mode = mode; d.k0 = (r / ntn) * 64; d.n0 = (r % ntn) * 256;
  };
  {
    f32x4 v[8]; TrItem cur, nxt;
    int it = bid;
    if (it < NIT) { decode(it, cur); tr_load(cur, v); }
    while (it < NIT) {
      tr_to_lds(v, lds);
      __syncthreads();
      const int itn = it + G;
      if (itn < NIT) { decode(itn, nxt); tr_load(nxt, v); }
      tr_store(cur, lds);
      __syncthreads();
      cur = nxt; it = itn;
    }
  }
  { const int gt = bid * 512 + tid, gs = G * 512;
    const u32x4 z = {0u, 0u, 0u, 0u};
    u32x4* zp = (u32x4*)(win + (size_t)INW * 1024);
    for (int e = gt; e < (LDP - INW) * 1024 / 8; e += gs) zp[e] = z;
    if (bid == 0) ((u32x4*)(p.ws + OFF_KVC + 2 * SZ_KVC1 * 2))[tid] = z; }
  if (bid >= G - 16) {
    const int w = bid - (G - 16), kv = w >> 3, hd = (w & 7) * 32 + (tid & 31), kq = tid >> 5;
    const float* pos = p.in[kv ? 13 : 10]; const float* w1 = p.in[kv ? 14 : 11];
    float s = 0.f;
    for (int k = kq * 128; k < kq * 128 + 128; ++k) s = __builtin_fmaf(pos[k], w1[(size_t)k * 256 + hd], s);
    LAS float* red = (LAS float*)lds;
    __syncthreads();
    red[tid] = s;
    __syncthreads();
    if (tid < 32) { float a = 0.f;
#pragma unroll
      for (int q = 0; q < 16; ++q) a += red[q * 32 + tid];
      ((float*)(p.ws + OFF_CB))[kv * 256 + hd] = a; }
    __syncthreads();
  }
}
DI void norm_mod_phase(const float* X, bf16_t* U, const float* g, const float* mod, int sh_off, int sc_off, int nwg) {
  const int tid_ = otid(), lane = tid_ & 63, gw = blockIdx.x * 8 + (tid_ >> 6), NW = nwg * 8;
  for (int row = gw; row < MTOK; row += NW) {
    const int b = row >> 11; const f32x4* xr = (const f32x4*)(X + (size_t)row * DM) + lane;
    f32x4 v[4]; float ss = 0.f;
#pragma unroll
    for (int j = 0; j < 4; ++j) { v[j] = xr[64 * j]; ss += (v[j][0] * v[j][0] + v[j][1] * v[j][1]) + (v[j][2] * v[j][2] + v[j][3] * v[j][3]); }
    const float rs = 1.0f / sqrtf(wave_sum(ss) * (1.f / DM) + 1e-6f);
    u32x2* o = (u32x2*)(U + (size_t)row * DM) + lane;
#pragma unroll
    for (int j = 0; j < 4; ++j) { const int col = lane * 4 + 256 * j;
      const f32x4 gg = *(const f32x4*)(g + col), sh = *(const f32x4*)(mod + b * MODW + sh_off + col), sc = *(const f32x4*)(mod + b * MODW + sc_off + col);
      const f32x4 u = (v[j] * rs) * gg * (1.f + sc) + sh;
      u32x2 w; w.x = pk2(u[0], u[1]); w.y = pk2(u[2], u[3]); o[64 * j] = w; }
  }
}
DI void final_norm_phase(float* X, const float* g) {
  const int tid_ = otid(), lane = tid_ & 63, gw = blockIdx.x * 8 + (tid_ >> 6), NW = gridDim.x * 8;
  for (int row = gw; row < MTOK; row += NW) {
    f32x4* xr = (f32x4*)(X + (size_t)row * DM) + lane;
    f32x4 v[4]; float ss = 0.f;
#pragma unroll
    for (int j = 0; j < 4; ++j) { v[j] = xr[64 * j]; ss += (v[j][0] * v[j][0] + v[j][1] * v[j][1]) + (v[j][2] * v[j][2] + v[j][3] * v[j][3]); }
    const float rs = 1.0f / sqrtf(wave_sum(ss) * (1.f / DM) + 1e-6f);
#pragma unroll
    for (int j = 0; j < 4; ++j) { const f32x4 gg = *(const f32x4*)(g + lane * 4 + 256 * j); xr[64 * j] = (v[j] * rs) * gg; }
  }
}
DI void final_scale_phase(const bf16_t* HG, const float* ps, float* out) {
  const int tid_ = otid(), lane = tid_ & 63, gw = blockIdx.x * 8 + (tid_ >> 6), NW = gridDim.x * 8;
  for (int row = gw; row < MTOK; row += NW) {
    const float rs = row_rs(ps, row);
    const u32x4* hr = (const u32x4*)(HG + (size_t)row * DM) + lane; f32x4* o = (f32x4*)(out + (size_t)row * DM) + 2 * lane;
#pragma unroll
    for (int j = 0; j < 2; ++j) { const u32x4 w = hr[64 * j];
      f32x4 a = {bflo(w.x), bfhi(w.x), bflo(w.y), bfhi(w.y)}, b = {bflo(w.z), bfhi(w.z), bflo(w.w), bfhi(w.w)};
      o[128 * j] = a * rs; o[128 * j + 1] = b * rs; }
  }
}
DI void cmp2_phase(const Params& p, LAS unsigned char* lds) {
  const int tid = otid(), lane = tid & 63, wid = tid >> 6;
  const bf16_t* hid = (const bf16_t*)(p.ws + OFF_HID); bf16_t* kc = (bf16_t*)(p.ws + OFF_KC);
  LAS float* w2s = (LAS float*)lds; LAS unsigned char* hids = lds + 65536;
  for (int it = blockIdx.x; it < 256; it += gridDim.x) {
    const int row0 = it * 32, kv = row0 >> 12; const float* w2 = p.in[kv ? 15 : 12];
#pragma unroll
    for (int i = 0; i < 8; ++i) ((LAS f32x4*)w2s)[tid + 512 * i] = ((const f32x4*)w2)[tid + 512 * i];
#pragma unroll
    for (int i = 0; i < 2; ++i) ((LAS u32x4*)hids)[tid + 512 * i] = ((const u32x4*)(hid + (size_t)row0 * 256))[tid + 512 * i];
    __syncthreads();
    float acc[4] = {0.f, 0.f, 0.f, 0.f};
    for (int k8 = 0; k8 < 32; ++k8) {
      u32x4 hv[4];
#pragma unroll
      for (int rr = 0; rr < 4; ++rr) hv[rr] = *(const LAS u32x4*)(hids + ((wid * 4 + rr) * 256 + k8 * 8) * 2);
      float w[8];
#pragma unroll
      for (int e = 0; e < 8; ++e) w[e] = w2s[(k8 * 8 + e) * 64 + lane];
#pragma unroll
      for (int rr = 0; rr < 4; ++rr) {
        acc[rr] = __builtin_fmaf(bflo(hv[rr].x), w[0], acc[rr]); acc[rr] = __builtin_fmaf(bfhi(hv[rr].x), w[1], acc[rr]);
        acc[rr] = __builtin_fmaf(bflo(hv[rr].y), w[2], acc[rr]); acc[rr] = __builtin_fmaf(bfhi(hv[rr].y), w[3], acc[rr]);
        acc[rr] = __builtin_fmaf(bflo(hv[rr].z), w[4], acc[rr]); acc[rr] = __builtin_fmaf(bfhi(hv[rr].z), w[5], acc[rr]);
        acc[rr] = __builtin_fmaf(bflo(hv[rr].w), w[6], acc[rr]); acc[rr] = __builtin_fmaf(bfhi(hv[rr].w), w[7], acc[rr]);
      }
    }
#pragma unroll
    for (int rr = 0; rr < 4; ++rr) { const float s1 = __shfl_down(acc[rr], 1);
      if (!(lane & 1)) *(unsigned*)(kc + (size_t)(row0 + wid * 4 + rr) * 64 + lane) = pk2(acc[rr], s1); }
    __syncthreads();
  }
}

#define XB_TMO      128
#define XB_XCNT(j)  (256  + 64 * (j))
#define XB_XSUB(j)  (1280 + 64 * (j))
#define XB_XGEN(j)  (2304 + 64 * (j))
#define XB_TOP      3328
#define XB_TOPGEN   3392
#define XCD_BAR_WORDS 3456
#define XB_SPIN_CAP (1u << 18)
DI unsigned xb_ld(unsigned* p) { return __hip_atomic_load(p, __ATOMIC_RELAXED, __HIP_MEMORY_SCOPE_AGENT); }
DI unsigned xb_add(unsigned* p, unsigned v) { return __hip_atomic_fetch_add(p, v, __ATOMIC_RELAXED, __HIP_MEMORY_SCOPE_AGENT); }
DI unsigned xb_xcc_id() { return (unsigned)__builtin_amdgcn_s_getreg((3 << 11) | 20) & 0xFu; }
#define XB_SPIN(cond, bar) do { unsigned _sp = 0; while (cond) { __builtin_amdgcn_s_sleep(1); \
    if ((++_sp & 255u) == 0u) { if (xb_ld(&(bar)[XB_TMO])) break; if (_sp > XB_SPIN_CAP) { atomicAdd(&(bar)[XB_TMO], 1u); break; } } } } while (0)
struct XcdBarrier { unsigned* bar; unsigned x; volatile LAS unsigned* st; };
DI XcdBarrier xcd_barrier_post(unsigned* bar, volatile LAS unsigned* st) {
  XcdBarrier b; b.bar = bar; b.x = xb_xcc_id(); b.st = st;
  if (threadIdx.x == 0) (void)xb_add(&bar[XB_XCNT(b.x)], 1u);
  return b;
}
DI void xcd_barrier_complete(unsigned* bar, unsigned x, unsigned& nloc, unsigned& nx) {
  const unsigned G = gridDim.x * gridDim.y * gridDim.z;
  unsigned sum, cnt, mine, sp = 0u;
  for (;;) {
    sum = 0u; cnt = 0u; mine = 0u;
#pragma unroll
    for (unsigned j = 0; j < 16; ++j) { const unsigned c = xb_ld(&bar[XB_XCNT(j)]); sum += c; cnt += (c > 0u) ? 1u : 0u; mine = (j == x) ? c : mine; }
    if (sum == G) break;
    __builtin_amdgcn_s_sleep(1);
    if ((++sp & 255u) == 0u) { if (xb_ld(&bar[XB_TMO])) break; if (sp > XB_SPIN_CAP) { atomicAdd(&bar[XB_TMO], 1u); break; } }
  }
  nloc = mine > 0u ? mine : 1u; nx = cnt > 0u ? cnt : 1u;
}
DI void xcd_barrier(const XcdBarrier& b) {
  asm volatile("s_waitcnt vmcnt(0)" ::: "memory");
  __syncthreads();
  if (threadIdx.x == 0) {
    unsigned* bar = b.bar;
    __builtin_amdgcn_s_waitcnt(0);
    unsigned nloc = b.st[0], nx = b.st[1];
    if (nloc == 0u) { xcd_barrier_complete(bar, b.x, nloc, nx); b.st[0] = nloc; b.st[1] = nx; }
    const unsigned old = xb_add(&bar[XB_XSUB(b.x)], 1u);
    const unsigned gen = old / nloc;
    if (old + 1u == (gen + 1u) * nloc) {
      __builtin_amdgcn_fence(__ATOMIC_RELEASE, "agent");
      asm volatile("s_waitcnt vmcnt(0)" ::: "memory");
      const unsigned og = xb_add(&bar[XB_TOP], 1u);
      const unsigned tg = og / nx;
      if (og + 1u == (tg + 1u) * nx) xb_add(&bar[XB_TOPGEN], 1u);
      else XB_SPIN(xb_ld(&bar[XB_TOPGEN]) == tg, bar);
      __builtin_amdgcn_fence(__ATOMIC_ACQUIRE, "agent");
      xb_add(&bar[XB_XGEN(b.x)], 1u);
      asm volatile("s_waitcnt vmcnt(0)" ::: "memory");
    } else {
      XB_SPIN(xb_ld(&bar[XB_XGEN(b.x)]) == gen, bar);
      __builtin_amdgcn_fence(__ATOMIC_ACQUIRE, "agent");
      asm volatile("s_waitcnt vmcnt(0)" ::: "memory");
    }
  }
  __syncthreads();
}

extern __shared__ __attribute__((aligned(16))) unsigned char dyn_lds[];
constexpr int LDS_BYTES = 8 * HT_B + 16;
constexpr int NPHASE = 15;

__global__ void __launch_bounds__(512) mega(Params p) {
  LAS unsigned char* lds = (LAS unsigned char*)dyn_lds;
  cg::grid_group grid = cg::this_grid();
  const float* mod = (const float*)(p.ws + OFF_MOD);
  bf16_t* U = (bf16_t*)(p.ws + OFF_U); bf16_t* ACT = (bf16_t*)(p.ws + OFF_ACT);
#ifndef DUPMASK
#define DUPMASK 0
#endif
  if (p.ph_lo < 0) grid.sync();
  if (threadIdx.x == 0) { *(volatile LAS unsigned*)(lds + 8 * HT_B) = 0u; *(volatile LAS unsigned*)(lds + 8 * HT_B + 4) = 0u; }
  __syncthreads();
  (void)xcd_barrier_post((unsigned*)(p.ws + OFF_BAR), (volatile LAS unsigned*)(lds + 8 * HT_B));
#define GSYNC() do { unsigned* _bw = (unsigned*)(p.ws + OFF_BAR); asm volatile("" : "+s"(_bw)); XcdBarrier _xb; _xb.bar = _bw; _xb.x = xb_xcc_id(); _xb.st = (volatile LAS unsigned*)(lds + 8 * HT_B); xcd_barrier(_xb); } while (0)
#define PH_BEGIN(n) if (p.ph_lo <= (n) && (n) < p.ph_hi) { for (int rep = 0; rep < 1 + ((DUPMASK >> (n)) & 1); ++rep) { if (rep) GSYNC();
#define PH_END(n) } if ((n) + 1 < p.ph_hi) GSYNC(); }
  PH_BEGIN(0) phase0(p, lds); PH_END(0)
  float* PS = (float*)(p.ws + OFF_PS); float* GT = (float*)(p.ws + OFF_GT); float* SHW2 = (float*)(p.ws + OFF_SHW2); float* SHW3 = (float*)(p.ws + OFF_SHW3);
  bf16_t* HB = (bf16_t*)p.out;
  bf16_t* U3 = (bf16_t*)(p.ws + OFF_YA);
  PH_BEGIN(1)
    const int G1 = gridDim.x, nsh = (G1 > 2 * NSHU) ? NSHU : 0, nwg = G1 - nsh;
    if ((int)blockIdx.x >= nwg) {
      const int tid = otid(), w = blockIdx.x - nwg; const bool second = w >= 17; const int pn = second ? w - 17 : w;
      bf16_t* slot = (bf16_t*)(p.ws + OFF_SH) + (size_t)w * 256 * 1024;
      { const int b = tid >> 5, k0 = (tid & 31) * 32; const float* s = mod + (second ? 6144 : 3072) + b * MODW + k0; bf16_t* d = slot + b * 1024 + k0;
#pragma unroll
        for (int i = 0; i < 4; ++i) { const f32x4 x0 = *(const f32x4*)(s + 8 * i), x1 = *(const f32x4*)(s + 8 * i + 4);
          u32x4 wv; wv.x = pk2(x0[0], x0[1]); wv.y = pk2(x0[2], x0[3]); wv.z = pk2(x1[0], x1[1]); wv.w = pk2(x1[2], x1[3]); *(u32x4*)(d + 8 * i) = wv; } }
      asm volatile("s_waitcnt vmcnt(0)" ::: "memory");
      __syncthreads();
      gemm_stream(OneUnit{slot, (const bf16_t*)(p.ws + (second ? OFF_WGU2 : OFF_WIN)) + (size_t)pn * 256 * 1024, pn * 256}, 1024, 1024, 1024, EpiShW{second ? SHW3 : SHW2, second ? 5632 : LDP}, lds);
    } else {
      { const int tid = otid();
        for (int e = blockIdx.x * 512 + tid; e < 3 * NB * DM; e += nwg * 512) { const int which = e >> 14, b = (e >> 10) & 15, col = e & 1023;
          GT[e] = which == 2 ? p.in[24][col] : p.in[which ? 20 : 8][col] * (1.f + mod[b * MODW + (which ? 7168 : 4096) + col]); } }
      norm_mod_phase(p.in[0], U, p.in[4], mod, 0, 1024, nwg);
    }
  PH_END(1)
  PH_BEGIN(2) gemm_stream(StdUnits{U, 1024, (const bf16_t*)(p.ws + OFF_WGU1), 1024, 128, 22}, 1024, 1024, 1024, EpiGU<false>{ACT, nullptr, nullptr}, lds); PH_END(2)
#ifdef DUP2
  gemm_stream(StdUnits{U, 1024, (const bf16_t*)(p.ws + OFF_WGU1), 1024, 128, 22}, 1024, 1024, 1024, EpiGU<false>{ACT, nullptr, nullptr}, lds); GSYNC();
#endif
  PH_BEGIN(3) gemm_stream(StdUnits{ACT, FF, (const bf16_t*)(p.ws + OFF_WD1), FF, 128, 4}, FF, FF, FF, EpiResN<false, true, 1>{p.in[0], HB, mod + 2048, GT, U, PS}, lds); PH_END(3)
  PH_BEGIN(5) gemm_stream(StdUnits{U, 1024, (const bf16_t*)(p.ws + OFF_WIN), 1024, 128, 17}, 1024, 1024, 1024, EpiProj{ACT, (bf16_t*)(p.ws + OFF_KVC), PS, SHW2}, lds); PH_END(5)
  PH_BEGIN(6)
    gemm_stream(CmpUnits{(const bf16_t*)(p.ws + OFF_KVC), (const bf16_t*)(p.ws + OFF_W1T)}, 1024, 2048, 2048, EpiHid2{(bf16_t*)(p.ws + OFF_HID), (const float*)(p.ws + OFF_CB)}, lds);
    if (gridDim.x > 64) { if (blockIdx.x >= 32) for (int it = blockIdx.x - 32; it < 1024; it += gridDim.x - 32) swa_unit(p, it, lds); }
    else for (int it = blockIdx.x; it < 1024; it += gridDim.x) swa_unit(p, it, lds);
  PH_END(6)
  PH_BEGIN(7) cmp2_phase(p, lds); PH_END(7)
  PH_BEGIN(8)
    if (gridDim.x == 256) {
      const int w = blockIdx.x, q = w & 31, hi = w >> 5;
      for (int k = 0; k < 4; ++k) { const int q2 = (k & 2) ? ((q + 16) & 31) : q, qt = (k & 1) ? 31 - q2 : q2, bg = hi * 4 + k;
        nsa_unit(p, (bg << 5) | qt, lds); }
    } else for (int it = blockIdx.x; it < 1024; it += gridDim.x) nsa_unit(p, it, lds);
  PH_END(8)
  PH_BEGIN(9)
    gemm_stream(UpUnits{(const bf16_t*)(p.ws + OFF_YA), (const bf16_t*)(p.ws + OFF_YB), (const bf16_t*)(p.ws + OFF_WUPA), (const bf16_t*)(p.ws + OFF_WUPB)}, 512, 512, 512, EpiUp{ACT, U}, lds);
  PH_END(9)
  PH_BEGIN(10) gemm_stream(StdUnits{U, 1024, (const bf16_t*)(p.ws + OFF_WOUT), 1024, 128, 4}, 1024, 1024, 1024, EpiResN<true, true, 2>{HB, HB, mod + 5 * 1024, GT + NB * DM, U3, PS}, lds); PH_END(10)
  PH_BEGIN(12) gemm_stream(StdUnits{U3, 1024, (const bf16_t*)(p.ws + OFF_WGU2), 1024, 128, 22}, 1024, 1024, 1024, EpiGU<true>{ACT, PS, SHW3}, lds); PH_END(12)
  PH_BEGIN(13) gemm_stream(StdUnits{ACT, FF, (const bf16_t*)(p.ws + OFF_WD2), FF, 128, 4}, FF, FF, FF, EpiResN<true, false, 1>{HB, nullptr, mod + 8 * 1024, GT + 2 * NB * DM, U, PS}, lds); PH_END(13)
  PH_BEGIN(14) final_scale_phase(U, PS, p.out); PH_END(14)
}

extern "C" void kernel_launch(void* const* d_in, const int* in_sizes, int n_in, void* d_out, int out_size, void* d_ws, size_t ws_size, hipStream_t stream) {
  static int grid = 0;
  if (grid == 0) {
    if (n_in != 25 || out_size != MTOK * DM || ws_size < WS_END) { fprintf(stderr, "kernel_launch: unexpected shapes (n_in %d out %d ws %zu need %zu)\n", n_in, out_size, ws_size, (size_t)WS_END); grid = -1; return; }
    int dev = 0, cus = 0, per_cu = 0;
    hipGetDevice(&dev);
    hipDeviceGetAttribute(&cus, hipDeviceAttributeMultiprocessorCount, dev);
    hipFuncSetAttribute((const void*)mega, hipFuncAttributeMaxDynamicSharedMemorySize, LDS_BYTES);
    hipOccupancyMaxActiveBlocksPerMultiprocessor(&per_cu, (const void*)mega, 512, LDS_BYTES);
    if (per_cu < 1) { fprintf(stderr, "kernel_launch: occupancy query reports %d blocks per CU\n", per_cu); grid = -1; return; }
    grid = cus;
  }
  if (grid < 0) return;
  if (hipMemsetAsync((char*)d_ws + OFF_BAR, 0, XCD_BAR_WORDS * 4, stream) != hipSuccess) { fprintf(stderr, "kernel_launch: memset of the barrier words failed\n"); return; }
  Params p{};
  for (int i = 0; i < 25; ++i) p.in[i] = (const float*)d_in[i];
  p.out = (float*)d_out; p.ws = (unsigned char*)d_ws;
#if NLAUNCH == 1
  p.ph_lo = 0; p.ph_hi = NPHASE;
  void* args[] = {&p};
  hipError_t e = hipLaunchCooperativeKernel((const void*)mega, dim3(grid), dim3(512), args, LDS_BYTES, stream);
  if (e != hipSuccess) fprintf(stderr, "cooperative launch failed: %s (grid %d)\n", hipGetErrorString(e), grid);
#else
  for (int ph = 0; ph < NPHASE; ++ph) {
    p.ph_lo = ph; p.ph_hi = ph + 1;
    void* args[] = {&p};
    hipError_t e = hipLaunchCooperativeKernel((const void*)mega, dim3(grid), dim3(512), args, LDS_BYTES, stream);
    if (e != hipSuccess) { fprintf(stderr, "launch of phase %d failed: %s\n", ph, hipGetErrorString(e)); break; }
  }
#endif
}
```
